# Optimizing an MI355X kernel written in HIP

```python
import math
import jax, jax.numpy as jnp
from jax import lax
import numpy as np

D_MODEL = 1024
BATCH = 4
SEQ = 8192
DEPTH = 1

CHUNK = 64
Q_BLOCK = 128
HEAD_DIM = 64
ROPE_DIM = 64
ROPE_THETA = 10000.0
A_WIDTH = D_MODEL // 2
A_HEADS = A_WIDTH // HEAD_DIM
IDX_HEADS = 8
IDX_DIM = 64
IDX_TOPK_MAX = 256
B_WIDTH = D_MODEL - A_WIDTH
B_QK_DIM = HEAD_DIM
B_V_DIM = 2 * B_QK_DIM
B_HEADS = B_WIDTH // B_V_DIM
SPLIT_SIZES = (
    A_HEADS * HEAD_DIM, A_HEADS * HEAD_DIM, A_HEADS * HEAD_DIM,
    IDX_HEADS * IDX_DIM, IDX_DIM, IDX_HEADS,
    B_HEADS * 2 * B_QK_DIM, B_HEADS * 2 * B_QK_DIM, B_HEADS * B_V_DIM,
)
PROJ_WIDTH = sum(SPLIT_SIZES)
SPLIT_POINTS = tuple(int(v) for v in np.cumsum(SPLIT_SIZES)[:-1])
N_EXPERTS = 64
TOP_K = 8
N_GROUPS = 8
TOPK_GROUPS = 4
EXPERT_DIM = 256
SHARED_DIM = 256
ROUTED_SCALE = 2.5
MOE_BLOCK = 256
PLE_DIM = 256
LN_EPS = 1e-5
RMS_EPS = 1e-5
DEEPNORM_ALPHA = (2.0 * DEPTH) ** 0.25
DEEPNORM_BETA = (8.0 * DEPTH) ** -0.25

kernel_name = "hybrid_dsa_diffattn_moe_deepnorm_block"


def layer_norm(x, g, b):
    xf = x.astype(jnp.float32)
    mu = jnp.mean(xf, axis=-1, keepdims=True)
    var = jnp.mean(jnp.square(xf - mu), axis=-1, keepdims=True)
    return ((xf - mu) * lax.rsqrt(var + LN_EPS) * g + b).astype(x.dtype)


def rope_tables(positions):
    inv = ROPE_THETA ** (-jnp.arange(0, ROPE_DIM, 2, dtype=jnp.float32) / ROPE_DIM)
    ang = positions.astype(jnp.float32)[..., None] * inv
    return jnp.cos(ang), jnp.sin(ang)


def apply_rope(x, cos, sin):
    x1, x2 = jnp.split(x.astype(jnp.float32), 2, axis=-1)
    c = cos[:, :, None, :]
    s = sin[:, :, None, :]
    return jnp.concatenate([x1 * c - x2 * s, x2 * c + x1 * s], axis=-1).astype(x.dtype)


def dsa_mixer(q, k, v, q_idx, k_idx, w_idx, n_keep):
    bsz, seq, n_heads, dh = q.shape
    n_blocks = seq // Q_BLOCK
    key_chunk = jnp.arange(seq) // CHUNK
    attn_scale = dh ** -0.5
    w_scale = (IDX_HEADS ** -0.5) * (IDX_DIM ** -0.5)

    def block(i):
        t0 = i * Q_BLOCK
        qb = lax.dynamic_slice_in_dim(q, t0, Q_BLOCK, axis=1)
        qib = lax.dynamic_slice_in_dim(q_idx, t0, Q_BLOCK, axis=1)
        wb = lax.dynamic_slice_in_dim(w_idx, t0, Q_BLOCK, axis=1).astype(jnp.float32) * w_scale
        q_chunk = (t0 + jnp.arange(Q_BLOCK)) // CHUNK
        admissible = key_chunk[None, :] <= q_chunk[:, None]
        rel = jax.nn.relu(jnp.einsum('bthd,bsd->bths', qib, k_idx,
                                     preferred_element_type=jnp.float32))
        score = jnp.einsum('bth,bths->bts', wb, rel)
        score = jnp.where(admissible[None], score, -jnp.inf)
        _, sel = lax.top_k(score, n_keep)
        sel_ok = key_chunk[sel] <= q_chunk[None, :, None]
        k_sel = jax.vmap(lambda kb, ib: kb[ib])(k, sel)
        v_sel = jax.vmap(lambda vb, ib: vb[ib])(v, sel)
        logits = jnp.einsum('bthd,btkhd->bhtk', qb, k_sel,
                            preferred_element_type=jnp.float32) * attn_scale
        logits = jnp.where(sel_ok[:, None], logits, -jnp.inf)
        prob = jax.nn.softmax(logits, axis=-1).astype(v.dtype)
        return jnp.einsum('bhtk,btkhd->bthd', prob, v_sel)

    out = lax.map(block, jnp.arange(n_blocks))
    return out.transpose(1, 0, 2, 3, 4).reshape(bsz, seq, n_heads * dh)


def diff_mixer(q, k, v, lam, subln_g, lambda_init):
    bsz, seq, n_heads, _, dq = q.shape
    dv = v.shape[-1]
    n_blocks = seq // Q_BLOCK
    key_chunk = jnp.arange(seq) // CHUNK
    scale = dq ** -0.5

    def block(i):
        t0 = i * Q_BLOCK
        qb = lax.dynamic_slice_in_dim(q, t0, Q_BLOCK, axis=1)
        q_chunk = (t0 + jnp.arange(Q_BLOCK)) // CHUNK
        mask = key_chunk[None, :] <= q_chunk[:, None]
        logits = jnp.einsum('bthmd,bshmd->bhmts', qb, k,
                            preferred_element_type=jnp.float32) * scale
        logits = jnp.where(mask[None, None, None], logits, -jnp.inf)
        prob = jax.nn.softmax(logits, axis=-1)
        attn = prob[:, :, 0] - lam * prob[:, :, 1]
        return jnp.einsum('bhts,bshd->bthd', attn.astype(v.dtype), v)

    out = lax.map(block, jnp.arange(n_blocks))
    out = out.transpose(1, 0, 2, 3, 4).reshape(bsz, seq, n_heads, dv)
    of = out.astype(jnp.float32)
    of = of * lax.rsqrt(jnp.mean(jnp.square(of), axis=-1, keepdims=True) + RMS_EPS)
    of = of * subln_g * (1.0 - lambda_init)
    return of.astype(v.dtype).reshape(bsz, seq, n_heads * dv)


def moe(h, w_router, router_bias, w_exp_gate, w_exp_up, w_exp_down, w_sh_gate, w_sh_up, w_sh_down):
    bsz, seq, d = h.shape
    n_tok = bsz * seq
    xt = h.reshape(n_tok, d)
    scores = jax.nn.sigmoid(jnp.einsum('td,de->te', xt, w_router,
                                       preferred_element_type=jnp.float32))
    biased = scores + router_bias.astype(jnp.float32)
    grp = biased.reshape(n_tok, N_GROUPS, N_EXPERTS // N_GROUPS)
    grp_score = jnp.sum(lax.top_k(grp, 2)[0], axis=-1)
    _, top_g = lax.top_k(grp_score, TOPK_GROUPS)
    gmask = jnp.any(top_g[..., None] == jnp.arange(N_GROUPS), axis=-2)
    emask = jnp.repeat(gmask, N_EXPERTS // N_GROUPS, axis=-1)
    _, eidx = lax.top_k(jnp.where(emask, biased, -jnp.inf), TOP_K)
    gate = jnp.take_along_axis(scores, eidx, axis=-1)
    gate = gate / jnp.sum(gate, axis=-1, keepdims=True) * ROUTED_SCALE

    n_assign = n_tok * TOP_K
    flat_e = eidx.reshape(n_assign)
    flat_tok = jnp.repeat(jnp.arange(n_tok, dtype=jnp.int32), TOP_K)
    flat_w = gate.reshape(n_assign)
    order = jnp.argsort(flat_e)
    e_sorted = flat_e[order]
    counts = jnp.zeros((N_EXPERTS,), jnp.int32).at[flat_e].add(1)
    padded = (counts + MOE_BLOCK - 1) // MOE_BLOCK * MOE_BLOCK
    start = jnp.cumsum(counts) - counts
    pend = jnp.cumsum(padded)
    pstart = pend - padded
    dest = pstart[e_sorted] + (jnp.arange(n_assign, dtype=jnp.int32) - start[e_sorted])
    n_blocks = (n_assign + N_EXPERTS * (MOE_BLOCK - 1) + MOE_BLOCK - 1) // MOE_BLOCK
    n_rows = n_blocks * MOE_BLOCK
    tok_buf = jnp.zeros((n_rows,), jnp.int32).at[dest].set(flat_tok[order])
    w_buf = jnp.zeros((n_rows,), gate.dtype).at[dest].set(flat_w[order])
    blk_e = jnp.minimum(jnp.searchsorted(pend, jnp.arange(n_blocks, dtype=jnp.int32) * MOE_BLOCK,
                                         side='right'), N_EXPERTS - 1)

    def step(acc, b):
        toks = lax.dynamic_slice_in_dim(tok_buf, b * MOE_BLOCK, MOE_BLOCK)
        wts = lax.dynamic_slice_in_dim(w_buf, b * MOE_BLOCK, MOE_BLOCK)
        e = blk_e[b]
        xb = xt[toks]
        hid = jax.nn.silu(xb @ w_exp_gate[e]) * (xb @ w_exp_up[e])
        y = (hid @ w_exp_down[e]) * wts[:, None]
        return acc.at[toks].add(y.astype(acc.dtype)), None

    routed, _ = lax.scan(step, jnp.zeros_like(xt), jnp.arange(n_blocks))
    shared = (jax.nn.silu(xt @ w_sh_gate) * (xt @ w_sh_up)) @ w_sh_down
    return (routed + shared).reshape(bsz, seq, d)


def setup_inputs(seed: int = 0) -> dict:
    key = jax.random.key(seed)
    ks = jax.random.split(key, 24)

    def nrm(k, shape, scale):
        return jax.random.normal(k, shape, jnp.float32) * scale

    d = D_MODEL
    col_scale = jnp.concatenate([
        jnp.ones((2 * A_HEADS * HEAD_DIM,), jnp.float32),
        jnp.full((A_HEADS * HEAD_DIM,), DEEPNORM_BETA, jnp.float32),
        jnp.ones((IDX_HEADS * IDX_DIM + IDX_DIM + IDX_HEADS + 2 * B_HEADS * 2 * B_QK_DIM,), jnp.float32),
        jnp.full((B_HEADS * B_V_DIM,), DEEPNORM_BETA, jnp.float32),
    ])
    return {
        "x": nrm(ks[0], (BATCH, SEQ, d), 1.0),
        "p": nrm(ks[1], (DEPTH, BATCH, SEQ, PLE_DIM), 1.0),
        "positions": jnp.broadcast_to(jnp.arange(SEQ, dtype=jnp.int32), (BATCH, SEQ)),
        "ln_emb_g": 1.0 + nrm(ks[2], (d,), 0.02),
        "ln_emb_b": nrm(ks[3], (d,), 0.02),
        "w_in": nrm(ks[4], (DEPTH, d, PROJ_WIDTH), d ** -0.5) * col_scale,
        "w_o": nrm(ks[5], (DEPTH, d, d), DEEPNORM_BETA * d ** -0.5),
        "diff_lq1": nrm(ks[6], (DEPTH, B_QK_DIM), 0.1),
        "diff_lk1": nrm(ks[7], (DEPTH, B_QK_DIM), 0.1),
        "diff_lq2": nrm(ks[8], (DEPTH, B_QK_DIM), 0.1),
        "diff_lk2": nrm(ks[9], (DEPTH, B_QK_DIM), 0.1),
        "diff_subln_g": 1.0 + nrm(ks[10], (DEPTH, B_V_DIM), 0.02),
        "ln1_g": 1.0 + nrm(ks[11], (DEPTH, d), 0.02),
        "ln1_b": nrm(ks[12], (DEPTH, d), 0.02),
        "w_router": nrm(ks[13], (DEPTH, d, N_EXPERTS), d ** -0.5),
        "router_bias": nrm(ks[14], (DEPTH, N_EXPERTS), 0.01),
        "w_exp_gate": nrm(ks[15], (DEPTH, N_EXPERTS, d, EXPERT_DIM), d ** -0.5),
        "w_exp_up": nrm(ks[16], (DEPTH, N_EXPERTS, d, EXPERT_DIM), d ** -0.5),
        "w_exp_down": nrm(ks[17], (DEPTH, N_EXPERTS, EXPERT_DIM, d), DEEPNORM_BETA * EXPERT_DIM ** -0.5),
        "w_sh_gate": nrm(ks[18], (DEPTH, d, SHARED_DIM), d ** -0.5),
        "w_sh_up": nrm(ks[19], (DEPTH, d, SHARED_DIM), d ** -0.5),
        "w_sh_down": nrm(ks[20], (DEPTH, SHARED_DIM, d), DEEPNORM_BETA * SHARED_DIM ** -0.5),
        "ln2_g": 1.0 + nrm(ks[21], (DEPTH, d), 0.02),
        "ln2_b": nrm(ks[22], (DEPTH, d), 0.02),
        "w_ple_gate": nrm(jax.random.fold_in(ks[23], 0), (DEPTH, d, d), d ** -0.5),
        "b_ple_gate": nrm(jax.random.fold_in(ks[23], 1), (DEPTH, d), 0.02),
        "w_ple_proj": nrm(jax.random.fold_in(ks[23], 2), (DEPTH, PLE_DIM, d), 0.5 * PLE_DIM ** -0.5),
    }


def reference(x, p, positions, ln_emb_g, ln_emb_b, w_in, w_o, diff_lq1, diff_lk1, diff_lq2, diff_lk2,
              diff_subln_g, ln1_g, ln1_b, w_router, router_bias, w_exp_gate, w_exp_up, w_exp_down,
              w_sh_gate, w_sh_up, w_sh_down, ln2_g, ln2_b, w_ple_gate, b_ple_gate, w_ple_proj):
    bsz, seq, _ = x.shape
    n_keep = min(IDX_TOPK_MAX, seq // 4)
    cos, sin = rope_tables(positions)
    h = layer_norm(x, ln_emb_g, ln_emb_b)
    for i in range(DEPTH):
        lambda_init = 0.8 - 0.6 * math.exp(-0.3 * i)
        proj = jnp.einsum('bsd,de->bse', h, w_in[i])
        a_q, a_k, a_v, i_q, i_k, i_w, b_q, b_k, b_v = jnp.split(proj, SPLIT_POINTS, axis=-1)
        a_q = apply_rope(a_q.reshape(bsz, seq, A_HEADS, HEAD_DIM), cos, sin)
        a_k = apply_rope(a_k.reshape(bsz, seq, A_HEADS, HEAD_DIM), cos, sin)
        a_v = a_v.reshape(bsz, seq, A_HEADS, HEAD_DIM)
        i_q = apply_rope(i_q.reshape(bsz, seq, IDX_HEADS, IDX_DIM), cos, sin)
        i_k = apply_rope(i_k.reshape(bsz, seq, 1, IDX_DIM), cos, sin)[:, :, 0]
        out_a = dsa_mixer(a_q, a_k, a_v, i_q, i_k, i_w, n_keep)
        b_q = apply_rope(b_q.reshape(bsz, seq, B_HEADS * 2, B_QK_DIM), cos, sin)
        b_k = apply_rope(b_k.reshape(bsz, seq, B_HEADS * 2, B_QK_DIM), cos, sin)
        b_q = b_q.reshape(bsz, seq, B_HEADS, 2, B_QK_DIM)
        b_k = b_k.reshape(bsz, seq, B_HEADS, 2, B_QK_DIM)
        b_v = b_v.reshape(bsz, seq, B_HEADS, B_V_DIM)
        lam = (jnp.exp(jnp.sum(diff_lq1[i].astype(jnp.float32) * diff_lk1[i]))
               - jnp.exp(jnp.sum(diff_lq2[i].astype(jnp.float32) * diff_lk2[i])) + lambda_init)
        out_b = diff_mixer(b_q, b_k, b_v, lam, diff_subln_g[i], lambda_init)
        mix = jnp.einsum('bse,ed->bsd', jnp.concatenate([out_a, out_b], axis=-1), w_o[i])
        h = layer_norm(DEEPNORM_ALPHA * h + mix, ln1_g[i], ln1_b[i])
        ffn = moe(h, w_router[i], router_bias[i], w_exp_gate[i], w_exp_up[i], w_exp_down[i],
                  w_sh_gate[i], w_sh_up[i], w_sh_down[i])
        h = layer_norm(DEEPNORM_ALPHA * h + ffn, ln2_g[i], ln2_b[i])
        gate = jax.nn.sigmoid(jnp.einsum('bsd,de->bse', h, w_ple_gate[i]) + b_ple_gate[i])
        h = h + gate * jnp.einsum('bsk,kd->bsd', p[i], w_ple_proj[i])
    return h
```

```cpp
#include <hip/hip_runtime.h>
#include <cstdio>
#include <cstdint>

#define LAS __attribute__((address_space(3)))
#define GAS __attribute__((address_space(1)))
typedef unsigned short bf16_t;
typedef short bf16x8 __attribute__((ext_vector_type(8)));
typedef float f32x4 __attribute__((ext_vector_type(4)));
typedef float f32x2 __attribute__((ext_vector_type(2)));
typedef float f32x16 __attribute__((ext_vector_type(16)));
typedef unsigned u32x4 __attribute__((ext_vector_type(4)));
typedef unsigned u32x2 __attribute__((ext_vector_type(2)));

#ifndef MK_N_LAUNCHES
#define MK_N_LAUNCHES 1
#endif

constexpr int NB = 4, S = 8192, T = NB * S, D = 1024;
constexpr int NPROJ = 3840;
constexpr int NE = 64, NEX = 65;
constexpr int NR = 2, RT = T / NR, TBR = RT / 128;
constexpr int RROUTED = RT * 8, RROWS = RROUTED + RT;
constexpr float QSCALE = 0.125f * 1.4426950408889634f;
constexpr float WSCALE = 0.04419417382415922f;
constexpr float ALPHA = 1.189207115002721f;
constexpr float LAMBDA_INIT = 0.2f;
constexpr float LN_EPS = 1e-5f, RMS_EPS = 1e-5f;
constexpr float NEGBIG = -1.0e30f;

constexpr size_t MiB = 1u << 20;
constexpr size_t WS_CTL = 0, CTL_ZERO_BYTES = 256 * 1024;
constexpr size_t WS_STATS0 = 1 * MiB;
constexpr size_t WS_WRP = 1 * MiB + 512 * 1024;
constexpr size_t WS_IW = 2 * MiB;
constexpr size_t WS_CNTWG = 3 * MiB;
constexpr size_t WS_TABLES = 3 * MiB + 512 * 1024;
constexpr size_t WS_EIDX = 4 * MiB;
constexpr size_t WS_GATE = 5 * MiB;
constexpr size_t WS_SLOTOF = 6 * MiB;
constexpr size_t WS_TOKBUF = 7 * MiB;
constexpr size_t WS_GWBUF = 9 * MiB;
constexpr size_t WS_YST = 12 * MiB;
constexpr size_t WS_IK = 12 * MiB;
constexpr size_t WS_WIN = 16 * MiB;
constexpr size_t WS_WO = 24 * MiB;
constexpr size_t WS_WPG = 26 * MiB;
constexpr size_t WS_WPP = 28 * MiB;
constexpr size_t WS_WGU = 29 * MiB;
constexpr size_t WS_WD = 94 * MiB;
constexpr size_t WS_CS = 127 * MiB;
constexpr size_t WS_H0B = 136 * MiB;
constexpr size_t WS_AO = 136 * MiB;
constexpr size_t WS_PB = 200 * MiB;
constexpr size_t WS_AQ = 216 * MiB, WS_AK = 248 * MiB, WS_AVT = 280 * MiB, WS_IQ = 312 * MiB, WS_BQ = 344 * MiB, WS_BK = 376 * MiB, WS_BVT = 408 * MiB;
constexpr size_t WS_MASK = 440 * MiB;
constexpr size_t WS_STASH = 457 * MiB;
constexpr size_t WS_Y1 = 216 * MiB;
constexpr size_t WS_H1B = 127 * MiB;
constexpr size_t WS_SLOTS = 191 * MiB;
constexpr size_t OUT_HID = 0, OUT_SLOTS_SH = 80 * MiB;
constexpr size_t WS_PP = 447 * MiB;
constexpr size_t WS_IXA = 127 * MiB, WS_IXB = 457 * MiB; constexpr int IX_NA = 146;
constexpr size_t WS_END = 512 * MiB;

constexpr int CW_BAR = 1024;

__device__ __forceinline__ unsigned f2bf(float f) { unsigned u = __builtin_bit_cast(unsigned, f); return (u + 0x7fffu + ((u >> 16) & 1u)) >> 16; }
typedef __bf16 bf16x2_t __attribute__((ext_vector_type(2)));
__device__ __forceinline__ unsigned pk2(float lo, float hi) { f32x2 v = {lo, hi}; bf16x2_t b = __builtin_convertvector(v, bf16x2_t); return __builtin_bit_cast(unsigned, b); }
__device__ __forceinline__ float bf2f(unsigned short b) { return __builtin_bit_cast(float, (unsigned)b << 16); }
template <int CTRL> __device__ __forceinline__ float dppf(float v) { return __builtin_bit_cast(float, __builtin_amdgcn_update_dpp(0, __builtin_bit_cast(int, v), CTRL, 0xf, 0xf, true)); }
__device__ __forceinline__ float rdlane(float v, int l) { return __builtin_bit_cast(float, __builtin_amdgcn_readlane(__builtin_bit_cast(int, v), l)); }
__device__ __forceinline__ float wave_sum(float v) {
    v += dppf<0xB1>(v); v += dppf<0x4E>(v); v += dppf<0x124>(v); v += dppf<0x128>(v);
    return (rdlane(v, 0) + rdlane(v, 16)) + (rdlane(v, 32) + rdlane(v, 48));
}
__device__ __forceinline__ float wave_max(float v) {
    v = fmaxf(v, dppf<0xB1>(v)); v = fmaxf(v, dppf<0x4E>(v)); v = fmaxf(v, dppf<0x124>(v)); v = fmaxf(v, dppf<0x128>(v));
    return fmaxf(fmaxf(rdlane(v, 0), rdlane(v, 16)), fmaxf(rdlane(v, 32), rdlane(v, 48)));
}
__device__ __forceinline__ float max8(float v) {
    v = fmaxf(v, dppf<0xB1>(v)); v = fmaxf(v, dppf<0x4E>(v)); return fmaxf(v, dppf<0x141>(v));
}
__device__ __forceinline__ int crow(int r, int hi) { return (r & 3) + 8 * (r >> 2) + 4 * hi; }
__device__ __forceinline__ int swz16(int s) { return (s & ~12) | ((s & 4) << 1) | ((s & 8) >> 1); }
__device__ __forceinline__ unsigned lds_add(LAS unsigned* p, unsigned v) { return __hip_atomic_fetch_add(p, v, __ATOMIC_RELAXED, __HIP_MEMORY_SCOPE_WORKGROUP); }
__device__ __forceinline__ void swap32(float v, float& own_or_partner0, float& own_or_partner1) { float a = v, b = v;
    asm volatile("s_nop 1\n\tv_permlane32_swap_b32 %0, %1" : "+v"(a), "+v"(b)); own_or_partner0 = a; own_or_partner1 = b; }
__device__ __forceinline__ void swap16(float v, float& own_or_partner0, float& own_or_partner1) { float a = v, b = v;
    asm volatile("s_nop 1\n\tv_permlane16_swap_b32 %0, %1" : "+v"(a), "+v"(b)); own_or_partner0 = a; own_or_partner1 = b; }
__device__ __forceinline__ float xsum32(float v) { float a, b; swap32(v, a, b); return a + b; }
__device__ __forceinline__ float xsum16(float v) { float a, b; swap16(v, a, b); return a + b; }
__device__ __forceinline__ float xmax32(float v) { float a, b; swap32(v, a, b); return fmaxf(a, b); }
#define LDS_WAIT() asm volatile("s_waitcnt lgkmcnt(0)" ::: "memory")
#define VM_WAIT() asm volatile("s_waitcnt vmcnt(0)" ::: "memory")

namespace pg8 {
constexpr int BM = 256, BK = 64, HALF = 128, HTB = HALF * BK * 2, STAGE_BYTES = 8 * HTB;
__host__ __device__ __forceinline__ int lds_byte(int r, int c) { const int st = (r >> 4) * 2 + (c >> 5), rr = r & 15, cc = c & 31, ob = rr * 64 + cc * 2; return st * 1024 + (ob ^ (((ob >> 9) & 1) << 5)); }
__host__ __device__ __forceinline__ void stage_rc(int b, int& R, int& C) { const int st = b / 1024, sb = b % 1024, swz = sb ^ (((sb >> 9) & 1) << 5); R = (st >> 1) * 16 + swz / 64; C = (st & 1) * 32 + (swz % 64) / 2; }

struct Unit { const char* bt; int arow; int i0, i1, i2; };

template <class Epi, class Sched, bool PERM = false>
__device__ __forceinline__ void gemm_phase(LAS unsigned char* lds, const char* Abase, const int K, const Sched& S, const Epi& E) {
    const int tid = threadIdx.x, wid = __builtin_amdgcn_readfirstlane(tid >> 6), lane = tid & 63, wr = wid >> 2, wc = wid & 3, fr = lane & 15, fq = lane >> 4;
    const int nt = K / BK;
    int Rr[2], Cc[2]; unsigned voffB[2];
#pragma unroll
    for (int i = 0; i < 2; ++i) { stage_rc(tid * 16 + i * 8192, Rr[i], Cc[i]); const int rho = Rr[i] & 31; const int Rb = PERM ? ((Rr[i] & ~31) + 8 * ((rho & 15) >> 2) + 4 * (rho >> 4) + (rho & 3)) : Rr[i];
        voffB[i] = (unsigned)(Rb * K + Cc[i]) * 2u; }
    const size_t kstep = (size_t)(BK * 2);
    const size_t hstepB = (size_t)HALF * K * 2;
    const unsigned ldsw = (unsigned)wid * 1024u;
    const int aoff = lds_byte(wr * 64 + fr, fq * 8), boff = lds_byte(wc * 32 + fr, fq * 8);
#define PG8_SA(b, h) (((b) * 2 + (h)) * HTB)
#define PG8_SB(b, h) ((4 + (b) * 2 + (h)) * HTB)
#define PG8_STAGE_B(bufoff, gbase) do { _Pragma("unroll") for (int _i = 0; _i < 2; ++_i) \
        __builtin_amdgcn_global_load_lds((const unsigned*)((const char*)(gbase) + voffB[_i]), (LAS unsigned*)(lds + (bufoff) + ldsw + _i * 8192), 16, 0, 0); } while (0)
#define PG8_STAGE_A(bufoff, kt, off) do { _Pragma("unroll") for (int _i = 0; _i < 2; ++_i) \
        __builtin_amdgcn_global_load_lds((const unsigned*)(Abase + (kt) + (off)[_i]), (LAS unsigned*)(lds + (bufoff) + ldsw + _i * 8192), 16, 0, 0); } while (0)
#define PG8_LDA(dst, b, h) do { _Pragma("unroll") for (int m = 0; m < 4; ++m) _Pragma("unroll") for (int k = 0; k < 2; ++k) dst[m][k] = *(const LAS bf16x8*)(lds + PG8_SA(b, h) + aoff + m * 2048 + k * 1024); } while (0)
#define PG8_LDB(dst, b, h) do { _Pragma("unroll") for (int n = 0; n < 2; ++n) _Pragma("unroll") for (int k = 0; k < 2; ++k) dst[n][k] = *(const LAS bf16x8*)(lds + PG8_SB(b, h) + boff + n * 2048 + k * 1024); } while (0)
#define PG8_MMA(ai, bj, At, Bt) do { __builtin_amdgcn_s_setprio(1); _Pragma("unroll") for (int m = 0; m < 4; ++m) _Pragma("unroll") for (int n = 0; n < 2; ++n) _Pragma("unroll") for (int k = 0; k < 2; ++k) \
        acc[ai][bj][m][n] = __builtin_amdgcn_mfma_f32_16x16x32_bf16(Bt[n][k], At[m][k], acc[ai][bj][m][n], 0, 0, 0); __builtin_amdgcn_s_setprio(0); } while (0)
#define PG8_WAIT_V(n) asm volatile("s_waitcnt vmcnt(" #n ")" ::: "memory")
#define PG8_WAIT_L(n) asm volatile("s_waitcnt lgkmcnt(" #n ")" ::: "memory")
#define PG8_BAR __builtin_amdgcn_s_barrier()
#define PG8_SCHED __builtin_amdgcn_sched_barrier(0)
    Unit cur, nxt; int ui = 0;
    if (!S.next(0, cur)) return;
    f32x4 acc[2][2][4][2];
#pragma unroll
    for (int a = 0; a < 2; ++a)
#pragma unroll
        for (int b = 0; b < 2; ++b)
#pragma unroll
            for (int m = 0; m < 4; ++m)
#pragma unroll
                for (int n = 0; n < 2; ++n) acc[a][b][m][n] = (f32x4){0.f, 0.f, 0.f, 0.f};
    bf16x8 At[4][2], B0[2][2], B1[2][2];
    unsigned oC0[2], oC1[2], oN0[2], oN1[2];
    S.aoffs(cur, Rr, Cc, K, oC0, oC1);
    const char* cB = cur.bt;
    PG8_STAGE_B(PG8_SB(0, 0), cB); PG8_STAGE_B(PG8_SB(0, 1), cB + hstepB); PG8_STAGE_A(PG8_SA(0, 0), 0, oC0); PG8_STAGE_A(PG8_SA(0, 1), 0, oC1);
    if (wr == 1) PG8_BAR;
    PG8_WAIT_V(2); PG8_BAR;
    PG8_STAGE_B(PG8_SB(1, 0), cB + kstep); PG8_STAGE_A(PG8_SA(1, 0), kstep, oC0); PG8_STAGE_B(PG8_SB(1, 1), cB + hstepB + kstep);
    PG8_WAIT_V(6); PG8_BAR;
    for (;;) {
        const bool has_next = S.next(ui + 1, nxt);
        const char* nB = has_next ? nxt.bt : cB;
        if (has_next) S.aoffs(nxt, Rr, Cc, K, oN0, oN1); else { oN0[0] = oC0[0]; oN0[1] = oC0[1]; oN1[0] = oC1[0]; oN1[1] = oC1[1]; }
#pragma unroll 1
        for (int t = 0; t < nt; t += 2) {
            const bool last = (t == nt - 2);
            const size_t kt1 = (size_t)(t + 1) * kstep;
            const size_t kt2 = last ? 0 : (size_t)(t + 2) * kstep, kt3 = kt2 + kstep;
            const char* b2 = last ? nB : cB + (size_t)(t + 2) * kstep; const char* b3 = b2 + kstep;
            unsigned p0[2], p1[2];
            p0[0] = last ? oN0[0] : oC0[0]; p0[1] = last ? oN0[1] : oC0[1]; p1[0] = last ? oN1[0] : oC1[0]; p1[1] = last ? oN1[1] : oC1[1];
            PG8_LDB(B0, 0, 0); PG8_LDB(B1, 0, 1); PG8_SCHED; PG8_LDA(At, 0, 0); PG8_STAGE_A(PG8_SA(1, 1), kt1, oC1);
            PG8_WAIT_V(8); PG8_WAIT_L(0); PG8_BAR; PG8_MMA(0, 0, At, B0); PG8_MMA(0, 1, At, B1); PG8_BAR; PG8_SCHED;
            PG8_LDA(At, 0, 1); PG8_STAGE_B(PG8_SB(0, 0), b2); PG8_STAGE_B(PG8_SB(0, 1), b2 + hstepB); PG8_STAGE_A(PG8_SA(0, 0), kt2, p0);
            PG8_WAIT_V(8); PG8_WAIT_L(0); PG8_BAR; PG8_MMA(1, 0, At, B0); PG8_MMA(1, 1, At, B1); PG8_BAR; PG8_SCHED;
            PG8_LDB(B0, 1, 0); PG8_LDB(B1, 1, 1); PG8_SCHED; PG8_LDA(At, 1, 0); PG8_STAGE_A(PG8_SA(0, 1), kt2, p1);
            PG8_WAIT_V(8); PG8_WAIT_L(0); PG8_BAR; PG8_MMA(0, 0, At, B0); PG8_MMA(0, 1, At, B1); PG8_BAR; PG8_SCHED;
            PG8_LDA(At, 1, 1); PG8_STAGE_B(PG8_SB(1, 0), b3); PG8_STAGE_B(PG8_SB(1, 1), b3 + hstepB); PG8_STAGE_A(PG8_SA(1, 0), kt3, p0);
            PG8_WAIT_V(8); PG8_WAIT_L(0); PG8_BAR; PG8_MMA(1, 0, At, B0); PG8_MMA(1, 1, At, B1); PG8_BAR; PG8_SCHED;
        }
        if (wr == 0) PG8_BAR;
        { int fr_ = fr, fq_ = fq; asm volatile("" : "+v"(fr_), "+v"(fq_)); E(acc, cur, wr, wc, fr_, fq_); }
        if (!has_next) break;
#pragma unroll
        for (int a = 0; a < 2; ++a)
#pragma unroll
            for (int b = 0; b < 2; ++b)
#pragma unroll
                for (int m = 0; m < 4; ++m)
#pragma unroll
                    for (int n = 0; n < 2; ++n) acc[a][b][m][n] = (f32x4){0.f, 0.f, 0.f, 0.f};
        cur = nxt; cB = nB; oC0[0] = oN0[0]; oC0[1] = oN0[1]; oC1[0] = oN1[0]; oC1[1] = oN1[1]; ++ui;
        if (wr == 1) PG8_BAR;
    }
    PG8_WAIT_V(0);
    PG8_BAR;
#undef PG8_SA
#undef PG8_SB
#undef PG8_STAGE_A
#undef PG8_STAGE_B
#undef PG8_LDA
#undef PG8_LDB
#undef PG8_MMA
#undef PG8_WAIT_V
#undef PG8_WAIT_L
#undef PG8_BAR
#undef PG8_SCHED
}

struct DenseOrder {
    const char* Bt; int K; int nM, nN, nwg, G, c;
    __device__ void init(const void* Bt_, int M, int N, int K_, int G_, int c_) { Bt = (const char*)Bt_; K = K_; nM = M / BM; nN = N / BM; nwg = nM * nN; G = G_; c = c_; }
    __device__ __forceinline__ bool next(int i, Unit& u) const {
        const long L = (long)i * G + c; if (L >= nwg) return false;
        int wgid = (int)L; { const int q = nwg / 8, r = nwg % 8, xcd = wgid % 8, off = wgid / 8; wgid = (xcd < r ? xcd * (q + 1) : r * (q + 1) + (xcd - r) * q) + off; }
        const int nig = 8 * nN, gid = wgid / nig, fm = gid * 8, gsz = (nM - fm) < 8 ? (nM - fm) : 8;
        const int pm = fm + ((wgid % nig) % gsz), pn = (wgid % nig) / gsz;
        u.bt = Bt + (size_t)pn * BM * K * 2; u.arow = pm * BM; u.i0 = pm; u.i1 = pn; u.i2 = 0; return true;
    }
    __device__ __forceinline__ void aoffs(const Unit& u, const int (&R)[2], const int (&C)[2], int K_, unsigned (&o0)[2], unsigned (&o1)[2]) const {
#pragma unroll
        for (int i = 0; i < 2; ++i) { o0[i] = (unsigned)((u.arow + R[i]) * K_ + C[i]) * 2u; o1[i] = (unsigned)((u.arow + HALF + R[i]) * K_ + C[i]) * 2u; }
    }
};
}

#define XB_TMO      128
#define XB_XCNT(j)  (256  + 64 * (j))
#define XB_XSUB(j)  (1280 + 64 * (j))
#define XB_XGEN(j)  (2304 + 64 * (j))
#define XB_TOP      3328
#define XB_TOPGEN   3392
#define XCD_BAR_WORDS 3456
#define XB_SPIN_CAP (1u << 20)
__device__ __forceinline__ unsigned xb_ld(unsigned* p)              { return __hip_atomic_load(p, __ATOMIC_RELAXED, __HIP_MEMORY_SCOPE_AGENT); }
__device__ __forceinline__ unsigned xb_add(unsigned* p, unsigned v) { return __hip_atomic_fetch_add(p, v, __ATOMIC_RELAXED, __HIP_MEMORY_SCOPE_AGENT); }
__device__ __forceinline__ unsigned xb_xcc_id() { return (unsigned)__builtin_amdgcn_s_getreg((3 << 11) | 20) & 0xFu; }
#define XB_SPIN(cond, bar) do { unsigned _sp = 0; while (cond) { __builtin_amdgcn_s_sleep(1); \
    if ((++_sp & 255u) == 0u) { if (xb_ld(&(bar)[XB_TMO])) break; if (_sp > XB_SPIN_CAP) { atomicAdd(&(bar)[XB_TMO], 1u); break; } } } } while (0)
struct XcdBarrier { unsigned* bar; unsigned x; volatile LAS unsigned* st; };
__device__ __forceinline__ XcdBarrier xcd_barrier_post(unsigned* bar, volatile LAS unsigned* st) {
    XcdBarrier b; b.bar = bar; b.x = xb_xcc_id(); b.st = st;
    if (threadIdx.x == 0) (void)xb_add(&bar[XB_XCNT(b.x)], 1u);
    return b;
}
__device__ __forceinline__ void xcd_barrier_complete(unsigned* bar, unsigned x, unsigned& nloc, unsigned& nx) {
    const unsigned G = gridDim.x * gridDim.y * gridDim.z;
    unsigned sum, cnt, mine, sp = 0u;
    for (;;) {
        sum = 0u; cnt = 0u; mine = 0u;
#pragma unroll
        for (unsigned j = 0; j < 16; ++j) { const unsigned c = xb_ld(&bar[XB_XCNT(j)]); sum += c; cnt += (c > 0u) ? 1u : 0u; mine = (j == x) ? c : mine; }
        if (sum == G) break;
        __builtin_amdgcn_s_sleep(1);
        if ((++sp & 255u) == 0u) { if (xb_ld(&bar[XB_TMO])) break; if (sp > XB_SPIN_CAP) { atomicAdd(&bar[XB_TMO], 1u); break; } }
    }
    nloc = mine > 0u ? mine : 1u; nx = cnt > 0u ? cnt : 1u;
}
__device__ __forceinline__ void xcd_barrier(const XcdBarrier& b) {
    asm volatile("s_waitcnt vmcnt(0)" ::: "memory");
    __syncthreads();
    if (threadIdx.x == 0) {
        unsigned* bar = b.bar;
        __builtin_amdgcn_s_waitcnt(0);
        unsigned nloc = b.st[0], nx = b.st[1];
        if (nloc == 0u) { xcd_barrier_complete(bar, b.x, nloc, nx); b.st[0] = nloc; b.st[1] = nx; }
        const unsigned old = xb_add(&bar[XB_XSUB(b.x)], 1u);
        const unsigned gen = old / nloc;
        if (old + 1u == (gen + 1u) * nloc) {
            __builtin_amdgcn_fence(__ATOMIC_RELEASE, "agent");
            asm volatile("s_waitcnt vmcnt(0)" ::: "memory");
            const unsigned og = xb_add(&bar[XB_TOP], 1u);
            const unsigned tg = og / nx;
            if (og + 1u == (tg + 1u) * nx) xb_add(&bar[XB_TOPGEN], 1u);
            else XB_SPIN(xb_ld(&bar[XB_TOPGEN]) == tg, bar);
            __builtin_amdgcn_fence(__ATOMIC_ACQUIRE, "agent");
            xb_add(&bar[XB_XGEN(b.x)], 1u);
            asm volatile("s_waitcnt vmcnt(0)" ::: "memory");
        } else {
            XB_SPIN(xb_ld(&bar[XB_XGEN(b.x)]) == gen, bar);
            __builtin_amdgcn_fence(__ATOMIC_ACQUIRE, "agent");
            asm volatile("s_waitcnt vmcnt(0)" ::: "memory");
        }
    }
    __syncthreads();
}

constexpr int RING_BYTES = 131072;
constexpr int MISC_OFF = 143360;
constexpr int LDS_BYTES = 147456;

struct Args {
    const float* x; const float* p; const int* positions; const float* ln_emb_g; const float* ln_emb_b; const float* w_in; const float* w_o;
    const float* lq1; const float* lk1; const float* lq2; const float* lk2; const float* subln_g; const float* ln1_g; const float* ln1_b;
    const float* w_router; const float* router_bias; const float* w_eg; const float* w_eu; const float* w_ed; const float* w_sg; const float* w_su; const float* w_sd;
    const float* ln2_g; const float* ln2_b; const float* w_pg; const float* b_pg; const float* w_pp;
    float* out; unsigned char* ws; int ph_lo, ph_hi;
};

struct Ctx {
    LAS unsigned char* lds; int tid, lane, wave, vcu, G;
};

template <class ColMap>
__device__ __forceinline__ void p0_transpose_item(const float* W, int K, int N, bf16_t* WT, int nprime_cnt, LAS float* scr, int item, int lane, const ColMap& cm) {
    const int nblk = nprime_cnt / 32, kb = item / nblk, nb = item % nblk, k0 = 64 * kb, n0 = 32 * nb;
    const int sc = cm(n0 + (lane & 31));
#pragma unroll 8
    for (int i = 0; i < 32; ++i) { const int kk = 2 * i + (lane >> 5); scr[kk * 33 + (lane & 31)] = sc >= 0 ? __builtin_nontemporal_load(W + (size_t)(k0 + kk) * N + sc) : 0.f; }
    LDS_WAIT(); asm volatile("" ::: "memory");
    const int c = lane & 7;
#pragma unroll
    for (int j = 0; j < 4; ++j) { const int n = (lane >> 3) + 8 * j; const LAS float* s = scr + (8 * c) * 33 + n;
        u32x4 o; o.x = pk2(s[0 * 33], s[1 * 33]); o.y = pk2(s[2 * 33], s[3 * 33]); o.z = pk2(s[4 * 33], s[5 * 33]); o.w = pk2(s[6 * 33], s[7 * 33]);
        *(GAS u32x4*)(WT + (size_t)(n0 + n) * K + k0 + 8 * c) = o; }
    LDS_WAIT(); asm volatile("" ::: "memory");
}
__device__ __forceinline__ int seg_d(int q) { return 16 * ((q >> 5) & 1) + 32 * ((q >> 4) & 1) + (q & 15); }
struct MapWin { __device__ int operator()(int n) const { const int seg = n >> 6, d = seg_d(n & 63);
        if (seg < 33) return 64 * seg + d; if (seg < 57) return 64 * seg + d + 8; if (seg == 57) return d < 8 ? 2112 + d : -1; return -1; } };
struct MapId { __device__ int operator()(int n) const { return n; } };

__device__ __forceinline__ void ln_row(const float* xrow, const float* g, const float* bb, int lane, f32x4 (&v)[4], float& mean, float& rstd) {
    const GAS f32x4* xr = (const GAS f32x4*)xrow + lane; float s = 0.f;
#pragma unroll
    for (int j = 0; j < 4; ++j) { v[j] = xr[64 * j]; s += (v[j].x + v[j].y) + (v[j].z + v[j].w); }
    mean = wave_sum(s) * (1.f / D); float s2 = 0.f;
#pragma unroll
    for (int j = 0; j < 4; ++j) { const f32x4 d = v[j] - mean; s2 += (d.x * d.x + d.y * d.y) + (d.z * d.z + d.w * d.w); }
    rstd = 1.f / sqrtf(wave_sum(s2) * (1.f / D) + LN_EPS);
#pragma unroll
    for (int j = 0; j < 4; ++j) { const f32x4 gg = *((const GAS f32x4*)g + lane + 64 * j), b4 = *((const GAS f32x4*)bb + lane + 64 * j); v[j] = (v[j] - mean) * rstd * gg + b4; }
}
template <bool NT = false>
__device__ __forceinline__ void ln_rows4(const float* const (&xrow)[4], const float* g, const float* bb, int lane, f32x4 (&v)[4][4], float (&mean)[4], float (&rstd)[4]) {
#pragma unroll
    for (int r = 0; r < 4; ++r) { const GAS f32x4* xr = (const GAS f32x4*)xrow[r] + lane;
#pragma unroll
        for (int j = 0; j < 4; ++j) v[r][j] = NT ? __builtin_nontemporal_load((const f32x4*)(xr + 64 * j)) : xr[64 * j]; }
#pragma unroll
    for (int r = 0; r < 4; ++r) { float s = 0.f;
#pragma unroll
        for (int j = 0; j < 4; ++j) s += (v[r][j].x + v[r][j].y) + (v[r][j].z + v[r][j].w);
        mean[r] = wave_sum(s) * (1.f / D); float s2 = 0.f;
#pragma unroll
        for (int j = 0; j < 4; ++j) { const f32x4 d = v[r][j] - mean[r]; s2 += (d.x * d.x + d.y * d.y) + (d.z * d.z + d.w * d.w); }
        rstd[r] = 1.f / sqrtf(wave_sum(s2) * (1.f / D) + LN_EPS); }
#pragma unroll
    for (int j = 0; j < 4; ++j) { const f32x4 gg = *((const GAS f32x4*)g + lane + 64 * j), b4 = *((const GAS f32x4*)bb + lane + 64 * j);
#pragma unroll
        for (int r = 0; r < 4; ++r) v[r][j] = (v[r][j] - mean[r]) * rstd[r] * gg + b4; }
}
__device__ __forceinline__ void store_row_bf16(bf16_t* orow, int lane, const f32x4 (&v)[4]) {
    GAS u32x2* o8 = (GAS u32x2*)orow + lane;
#pragma unroll
    for (int j = 0; j < 4; ++j) { u32x2 w; w.x = pk2(v[j].x, v[j].y); w.y = pk2(v[j].z, v[j].w); o8[64 * j] = w; }
}

__device__ __forceinline__ void phase0(const Args& a, const Ctx& c) {
    LAS float* scr = (LAS float*)(c.lds + c.wave * 16384);
    unsigned char* ws = a.ws;
    const int gw = c.vcu * 8 + c.wave, NGW = c.G * 8;
    constexpr int I_IN = 16 * (NPROJ / 32), I_O = 16 * 32, I_PG = 16 * 32, I_PP = 4 * 32, I_GU = 16 * 16, I_D = 4 * 32;
    constexpr int NITEMS = I_IN + I_O + I_PG + I_PP + NEX * (I_GU + I_D);
    for (int it = gw; it < NITEMS; it += NGW) {
        int r = it;
        if (r < I_IN) { p0_transpose_item(a.w_in, D, 3656, (bf16_t*)(ws + WS_WIN), NPROJ, scr, r, c.lane, MapWin()); continue; } r -= I_IN;
        if (r < I_O) { p0_transpose_item(a.w_o, D, D, (bf16_t*)(ws + WS_WO), D, scr, r, c.lane, MapId()); continue; } r -= I_O;
        if (r < I_PG) { p0_transpose_item(a.w_pg, D, D, (bf16_t*)(ws + WS_WPG), D, scr, r, c.lane, MapId()); continue; } r -= I_PG;
        if (r < I_PP) { p0_transpose_item(a.w_pp, 256, D, (bf16_t*)(ws + WS_WPP), D, scr, r, c.lane, MapId()); continue; } r -= I_PP;
        const int e = r / (I_GU + I_D); r -= e * (I_GU + I_D);
        if (r < I_GU) {
            const float* wg = e < NE ? a.w_eg + (size_t)e * D * 256 : a.w_sg; const float* wu = e < NE ? a.w_eu + (size_t)e * D * 256 : a.w_su;
            bf16_t* WT = (bf16_t*)(ws + WS_WGU) + (size_t)e * 512 * D;
            const int nblk = 512 / 32, kb = r / nblk, nb = r % nblk, k0 = 64 * kb, n0 = 32 * nb; const int lane = c.lane;
            const int q = lane & 31; const float* src = (q < 16) ? wg : wu; const int sc = 16 * nb + (q & 15);
#pragma unroll 8
            for (int i = 0; i < 32; ++i) { const int kk = 2 * i + (lane >> 5); scr[kk * 33 + q] = __builtin_nontemporal_load(src + (size_t)(k0 + kk) * 256 + sc); }
            LDS_WAIT(); asm volatile("" ::: "memory");
            const int cc = lane & 7;
#pragma unroll
            for (int j = 0; j < 4; ++j) { const int n = (lane >> 3) + 8 * j; const LAS float* s = scr + (8 * cc) * 33 + n;
                u32x4 o; o.x = pk2(s[0 * 33], s[1 * 33]); o.y = pk2(s[2 * 33], s[3 * 33]); o.z = pk2(s[4 * 33], s[5 * 33]); o.w = pk2(s[6 * 33], s[7 * 33]);
                *(GAS u32x4*)(WT + (size_t)(n0 + n) * D + k0 + 8 * cc) = o; }
            LDS_WAIT(); asm volatile("" ::: "memory");
            continue;
        }
        r -= I_GU;
        { const float* wd = e < NE ? a.w_ed + (size_t)e * 256 * D : a.w_sd; p0_transpose_item(wd, 256, D, (bf16_t*)(ws + WS_WD) + (size_t)e * D * 256, D, scr, r, c.lane, MapId()); }
    }
    for (int idx = c.vcu * 512 + c.tid; idx < 65536; idx += c.G * 512) {
        const int jj = idx & 3, r32 = (idx >> 2) & 31, hi = (idx >> 7) & 1, i = (idx >> 8) & 15, et = (idx >> 12) & 1, sl = idx >> 13;
        ((float*)(ws + WS_WRP))[idx] = a.w_router[(size_t)(128 * sl + 8 * i + 4 * hi + jj) * 64 + 32 * et + r32]; }
    for (int mb = gw; mb < T; mb += 4 * NGW) {
        f32x4 v4[4][4]; float mean4[4], rstd4[4];
        const float* const xr4[4] = {a.x + (size_t)mb * D, a.x + (size_t)(mb + NGW) * D, a.x + (size_t)(mb + 2 * NGW) * D, a.x + (size_t)(mb + 3 * NGW) * D};
        ln_rows4<true>(xr4, a.ln_emb_g, a.ln_emb_b, c.lane, v4, mean4, rstd4);
#pragma unroll
        for (int r = 0; r < 4; ++r) { const int m = mb + r * NGW;
            store_row_bf16((bf16_t*)(ws + WS_H0B) + (size_t)m * D, c.lane, v4[r]);
            if (c.lane == 0) { float* st = (float*)(ws + WS_STATS0) + 2 * m; st[0] = mean4[r]; st[1] = rstd4[r]; } }
      for (int r = 0; r < 4; ++r) { const int m = mb + r * NGW;
        { const f32x4 pv = *((const GAS f32x4*)(a.p + (size_t)m * 256) + c.lane); u32x2 w; w.x = pk2(pv.x, pv.y); w.y = pk2(pv.z, pv.w); *((GAS u32x2*)((bf16_t*)(ws + WS_PB) + (size_t)m * 256) + c.lane) = w; }
        if (c.lane < 32) { const double inv = pow(10000.0, -(double)c.lane / 32.0); const double ang = (double)a.positions[m] * inv; double sn, cs; sincos(ang, &sn, &cs);
            ((float*)(ws + WS_CS))[(size_t)m * 32 + c.lane] = (float)cs; ((float*)(ws + WS_CS) + (size_t)T * 32)[(size_t)m * 32 + c.lane] = (float)sn; }
      }
    }
}

struct EpiProj {
    unsigned char* ws; LAS unsigned char* tl;
    __device__ __forceinline__ void operator()(const f32x4 (&acc)[2][2][4][2], const pg8::Unit& u, int wr, int wc, int fr, int fq) const {
        const int pm = u.i0, pn = u.i1;
        const float* cosT = (const float*)(ws + WS_CS); const float* sinT = cosT + (size_t)T * 32;
        const int hh = wc & 1, d1 = 16 * hh + 4 * fq;
        int seg[2]; bool rope[2], isv[2];
#pragma unroll
        for (int bj = 0; bj < 2; ++bj) { seg[bj] = (pn * 256 + 128 * bj + 32 * wc) >> 6; isv[bj] = (seg[bj] >= 16 && seg[bj] < 24) || (seg[bj] >= 49 && seg[bj] < 57); rope[bj] = !isv[bj] && seg[bj] < 57; }
#pragma unroll
        for (int ai = 0; ai < 2; ++ai) {
            f32x4 cs[4], sn[4];
            if (rope[0] || rope[1]) {
#pragma unroll
                for (int m = 0; m < 4; ++m) { const int row = pm * 256 + 128 * ai + 64 * wr + 16 * m + fr; cs[m] = *(const GAS f32x4*)(cosT + (size_t)row * 32 + d1); sn[m] = *(const GAS f32x4*)(sinT + (size_t)row * 32 + d1); }
            }
#pragma unroll
            for (int bj = 0; bj < 2; ++bj) {
                const int sg = seg[bj];
                if (sg >= 58) continue;
                if (sg == 57) {
                    if (hh == 0 && fq < 2) {
#pragma unroll
                        for (int m = 0; m < 4; ++m) { const int row = pm * 256 + 128 * ai + 64 * wr + 16 * m + fr;
                            *(GAS f32x4*)((float*)(ws + WS_IW) + (size_t)row * 8 + d1) = acc[ai][bj][m][0] * WSCALE; }
                    }
                } else if (isv[bj]) {
                    bf16_t* base; int hb;
                    if (sg < 24) { base = (bf16_t*)(ws + WS_AVT); hb = (sg - 16) * 64; }
                    else { base = (bf16_t*)(ws + WS_BVT); hb = ((sg - 49) >> 1) * 128 + ((sg - 49) & 1) * 64; }
                    LAS unsigned char* tb = tl + (wr * 4 + wc) * 1024; const int lane_ = fq * 16 + fr, dvl = lane_ >> 1, half = lane_ & 1;
                    const int dtrue = 16 * hh + 32 * (dvl >> 4) + (dvl & 15); const int pos = swz16(fr);
#pragma unroll
                    for (int m = 0; m < 4; ++m) { const int row0 = pm * 256 + 128 * ai + 64 * wr + 16 * m; const int b = row0 >> 13, s16 = row0 & 8191;
                        const f32x4 x1 = acc[ai][bj][m][0], x2 = acc[ai][bj][m][1];
#pragma unroll
                        for (int i = 0; i < 4; ++i) { *(LAS bf16_t*)(tb + (4 * fq + i) * 32 + pos * 2) = (bf16_t)f2bf(x1[i]); *(LAS bf16_t*)(tb + (16 + 4 * fq + i) * 32 + pos * 2) = (bf16_t)f2bf(x2[i]); }
                        LDS_WAIT(); asm volatile("" ::: "memory");
                        const u32x4 v = *(const LAS u32x4*)(tb + dvl * 32 + half * 16);
                        *(GAS u32x4*)(base + ((size_t)(b * 512 + hb + dtrue)) * S + s16 + half * 8) = v;
                        LDS_WAIT(); asm volatile("" ::: "memory"); }
                } else {
                    bf16_t* base; int stride, col; float sc = 1.f;
                    if (sg < 8) { base = (bf16_t*)(ws + WS_AQ); stride = 512; col = sg * 64; sc = QSCALE; }
                    else if (sg < 16) { base = (bf16_t*)(ws + WS_AK); stride = 512; col = (sg - 8) * 64; }
                    else if (sg < 32) { base = (bf16_t*)(ws + WS_IQ); stride = 512; col = (sg - 24) * 64; }
                    else if (sg == 32) { base = (bf16_t*)(ws + WS_IK); stride = 64; col = 0; }
                    else if (sg < 41) { base = (bf16_t*)(ws + WS_BQ); stride = 512; col = (sg - 33) * 64; sc = QSCALE; }
                    else { base = (bf16_t*)(ws + WS_BK); stride = 512; col = (sg - 41) * 64; }
#pragma unroll
                    for (int m = 0; m < 4; ++m) { const int row = pm * 256 + 128 * ai + 64 * wr + 16 * m + fr;
                        const f32x4 x1 = acc[ai][bj][m][0], x2 = acc[ai][bj][m][1];
                        const f32x4 o1 = (x1 * cs[m] - x2 * sn[m]) * sc, o2 = (x2 * cs[m] + x1 * sn[m]) * sc;
                        bf16_t* p = base + (size_t)row * stride + col + 2 * d1;
                        u32x4 w; w.x = pk2(o1[0], o1[1]); w.y = pk2(o1[2], o1[3]); w.z = pk2(o2[0], o2[1]); w.w = pk2(o2[2], o2[3]);
                        *(GAS u32x4*)p = w; }
                }
            }
            asm volatile("" ::: "memory");
        }
    }
};
struct EpiBf16 {
    bf16_t* out;
    __device__ __forceinline__ void operator()(const f32x4 (&acc)[2][2][4][2], const pg8::Unit& u, int wr, int wc, int fr, int fq) const {
        const int pm = u.i0, pn = u.i1;
#pragma unroll
        for (int ai = 0; ai < 2; ++ai)
#pragma unroll
            for (int m = 0; m < 4; ++m) { const int row = pm * 256 + 128 * ai + 64 * wr + 16 * m + fr;
#pragma unroll
                for (int bj = 0; bj < 2; ++bj) { const f32x4 v0 = acc[ai][bj][m][0], v1 = acc[ai][bj][m][1]; u32x4 w; w.x = pk2(v0[0], v0[1]); w.y = pk2(v0[2], v0[3]); w.z = pk2(v1[0], v1[1]); w.w = pk2(v1[2], v1[3]);
                    *(GAS u32x4*)(out + (size_t)row * D + pn * 256 + 128 * bj + 32 * wc + 8 * fq) = w; } }
    }
};
__device__ __forceinline__ void phase1(const Args& a, const Ctx& c) {
    { pg8::DenseOrder S1; S1.init(a.ws + WS_WIN, T, NPROJ, D, c.G, (int)blockIdx.x); EpiProj E{a.ws, c.lds + RING_BYTES};
      pg8::gemm_phase(c.lds, (const char*)(a.ws + WS_H0B), D, S1, E); }
}

constexpr int IX_CAP = 256, IX_NBIN = 520;
constexpr int IXL_CS = 0, IXL_CI = 32768, IXL_MASK = 66560, IXL_Q = 99328, IX_QSTR = 1168, IXL_SM = 136704;
__device__ __forceinline__ void indexer_unit(const Args& a, const Ctx& c, int b, int ch, int half) {
    unsigned char* ws = a.ws; LAS unsigned char* lds = c.lds;
    int tid = c.tid; asm volatile("" : "+v"(tid));
    const int lane = tid & 63, wave = c.wave, r32 = lane & 31, hi = lane >> 5;
    const int ntile = 2 * (ch + 1);
    const int m0 = b * S + ch * 64 + half * 32;
    const bf16_t* IQ = (const bf16_t*)(ws + WS_IQ); const bf16_t* IK = (const bf16_t*)(ws + WS_IK) + (size_t)b * S * 64;
    LAS unsigned* hist = (LAS unsigned*)(lds + IXL_CS);
    LAS float* candS = (LAS float*)(lds + IXL_CS); LAS int* candI = (LAS int*)(lds + IXL_CI);
    LAS unsigned* maskL = (LAS unsigned*)(lds + IXL_MASK);
    LAS float* hiL = (LAS float*)(lds + IXL_SM); LAS float* loL = hiL + 32; LAS int* needL = (LAS int*)(loL + 32); LAS unsigned* ccntL = (LAS unsigned*)(needL + 32);
#pragma unroll
    for (int i = 0; i < 4; ++i) { const int idx = tid + 512 * i, row = idx >> 6, chn = idx & 63;
        *(LAS u32x4*)(lds + IXL_Q + row * IX_QSTR + chn * 16) = *(const GAS u32x4*)(IQ + (size_t)(m0 + row) * 512 + chn * 8); }
    for (int i = tid; i < 32 * 512; i += 512) hist[i] = 0u;
    if (tid < 32) ccntL[tid] = 0u;
    float wq[8];
    { const f32x4 w0 = *(const GAS f32x4*)((const float*)(ws + WS_IW) + (size_t)(m0 + r32) * 8), w1 = *(const GAS f32x4*)((const float*)(ws + WS_IW) + (size_t)(m0 + r32) * 8 + 4);
      wq[0] = 0.5f * w0[0]; wq[1] = 0.5f * w0[1]; wq[2] = 0.5f * w0[2]; wq[3] = 0.5f * w0[3]; wq[4] = 0.5f * w1[0]; wq[5] = 0.5f * w1[1]; wq[6] = 0.5f * w1[2]; wq[7] = 0.5f * w1[3]; }
    float bt = 0.f;
#pragma unroll
    for (int h = 0; h < 8; ++h) bt += fabsf(wq[h]);
    const float inv = bt > 0.f ? 3.2f / bt : 0.f;
    __syncthreads();
    {
        const int q = tid >> 4, d0 = (tid & 15) * 4; const float* wrow = (const float*)(ws + WS_IW) + (size_t)(m0 + q) * 8;
        float acc4[4] = {0.f, 0.f, 0.f, 0.f};
#pragma unroll
        for (int h = 0; h < 8; ++h) { const float wh = 0.5f * wrow[h]; const u32x2 v = *(const LAS u32x2*)(lds + IXL_Q + q * IX_QSTR + h * 128 + d0 * 2);
            acc4[0] += wh * __builtin_bit_cast(float, v.x << 16); acc4[1] += wh * __builtin_bit_cast(float, v.x & 0xffff0000u);
            acc4[2] += wh * __builtin_bit_cast(float, v.y << 16); acc4[3] += wh * __builtin_bit_cast(float, v.y & 0xffff0000u); }
        u32x2 o; o.x = pk2(acc4[0], acc4[1]); o.y = pk2(acc4[2], acc4[3]);
        *(LAS u32x2*)(lds + IXL_Q + q * IX_QSTR + 1024 + d0 * 2) = o;
    }
    __syncthreads();
    const LAS unsigned char* qb = lds + IXL_Q + r32 * IX_QSTR + hi * 16;
    unsigned* scr = (unsigned*)(ws + ((int)blockIdx.x < IX_NA ? WS_IXA + (size_t)blockIdx.x * 524288 : WS_IXB + (size_t)((int)blockIdx.x - IX_NA) * 524288)) + lane;
    const float inv16 = inv * 128.f;
#define IX_LDQ(QF, h) do { _Pragma("unroll") for (int ks = 0; ks < 4; ++ks) QF[ks] = *(const LAS bf16x8*)(qb + (h) * 128 + ks * 32); } while (0)
#define IX_HEAD(X, QF) do { X = __builtin_amdgcn_mfma_f32_32x32x16_bf16(kf[0], QF[0], zero16, 0, 0, 0); \
        _Pragma("unroll") for (int ks = 1; ks < 4; ++ks) X = __builtin_amdgcn_mfma_f32_32x32x16_bf16(kf[ks], QF[ks], X, 0, 0, 0); } while (0)
#define IX_ACC(X, h) do { _Pragma("unroll") for (int r = 0; r < 16; ++r) { float t_ = __builtin_fmaf(wq[h], __builtin_fabsf(X[r]), sc[r]); asm volatile("" : "+v"(t_)); sc[r] = t_; } } while (0)
    {
        bf16x8 qreg[8][4], qlin[4];
#pragma unroll
        for (int h = 0; h < 8; ++h) IX_LDQ(qreg[h], h);
        IX_LDQ(qlin, 8);
        bf16x8 kf[4], kn[4];
        if (wave < ntile) {
#pragma unroll
            for (int ks = 0; ks < 4; ++ks) kn[ks] = *(const GAS bf16x8*)(IK + (size_t)(wave * 32 + r32) * 64 + 16 * ks + 8 * hi);
        }
        for (int w = wave; w < ntile; w += 8) {
#pragma unroll
            for (int ks = 0; ks < 4; ++ks) kf[ks] = kn[ks];
            if (w + 8 < ntile) {
#pragma unroll
                for (int ks = 0; ks < 4; ++ks) kn[ks] = *(const GAS bf16x8*)(IK + (size_t)((w + 8) * 32 + r32) * 64 + 16 * ks + 8 * hi);
            }
            const f32x16 zero16 = {0.f, 0.f, 0.f, 0.f, 0.f, 0.f, 0.f, 0.f, 0.f, 0.f, 0.f, 0.f, 0.f, 0.f, 0.f, 0.f};
            f32x16 sc, xa, xb;
            IX_HEAD(sc, qlin);
            IX_HEAD(xa, qreg[0]);
#pragma unroll
            for (int h = 0; h < 8; h += 2) {
                __builtin_amdgcn_sched_barrier(0); IX_HEAD(xb, qreg[h + 1]); __builtin_amdgcn_sched_barrier(0);
                IX_ACC(xa, h);
                __builtin_amdgcn_sched_barrier(0); if (h + 2 < 8) { IX_HEAD(xa, qreg[h + 2]); } __builtin_amdgcn_sched_barrier(0);
                IX_ACC(xb, h + 1);
            }
            __builtin_amdgcn_sched_barrier(0); IX_LDQ(qlin, 8);
            unsigned code[16];
#pragma unroll
            for (int r = 0; r < 16; ++r) { int cd = (int)__builtin_fmaf(sc[r], inv16, 32768.5f); cd = cd < 0 ? 0 : cd; cd = cd > 65535 ? 65535 : cd; code[r] = (unsigned)cd;
                lds_add(&hist[r32 * 512 + (cd >> 7)], 1u); }
#pragma unroll
            for (int i = 0; i < 8; ++i) scr[(size_t)(w * 8 + i) * 64] = code[2 * i] | (code[2 * i + 1] << 16);
        }
    }
#undef IX_HEAD
#undef IX_LDQ
#undef IX_ACC
    __syncthreads();
    LAS unsigned* hiC = (LAS unsigned*)hiL; LAS unsigned* loC = (LAS unsigned*)loL;
    {
        const int q = wave * 4 + (lane >> 4), sub = lane & 15;
        u32x4 hb[8];
#pragma unroll
        for (int i = 0; i < 8; ++i) hb[i] = *(const LAS u32x4*)(hist + q * 512 + 32 * sub + 4 * i);
        int cl = 0;
#pragma unroll
        for (int i = 0; i < 8; ++i) cl += (int)(hb[i].x + hb[i].y + hb[i].z + hb[i].w);
        int incl = cl;
#pragma unroll
        for (int o = 1; o < 16; o <<= 1) { const int t = __shfl_up(incl, o, 16); if (sub >= o) incl += t; }
        const int total = __shfl(incl, 15, 16);
        const int suf = total - incl;
        if (total < 256) { if (sub == 0) { hiC[q] = 0u; loC[q] = 0u; needL[q] = 0; } }
        else if (suf < 256 && suf + cl >= 256) {
            int run = suf, bsel = 0, nd = 0; bool done = false;
#pragma unroll
            for (int i = 7; i >= 0; --i)
#pragma unroll
                for (int e = 3; e >= 0; --e) { const int cn = (int)hb[i][e]; if (!done) { if (run + cn >= 256) { bsel = 32 * sub + 4 * i + e; nd = 256 - run; done = true; } else run += cn; } }
            hiC[q] = (unsigned)(bsel + 1) << 7; loC[q] = (unsigned)bsel << 7; needL[q] = nd;
        }
    }
    __syncthreads();
    {
        const unsigned hiT = hiC[r32], loT = loC[r32];
        LAS unsigned* candC = (LAS unsigned*)candS;
        unsigned pk[8], pn_[8];
        if (wave < ntile) {
#pragma unroll
            for (int i = 0; i < 8; ++i) pn_[i] = scr[(size_t)(wave * 8 + i) * 64];
        }
        for (int w = wave; w < ntile; w += 8) {
#pragma unroll
            for (int i = 0; i < 8; ++i) pk[i] = pn_[i];
            if (w + 8 < ntile) {
#pragma unroll
                for (int i = 0; i < 8; ++i) pn_[i] = scr[(size_t)((w + 8) * 8 + i) * 64];
            }
            unsigned bits = 0u;
#pragma unroll
            for (int r = 0; r < 16; ++r) { const unsigned cd = (r & 1) ? (pk[r >> 1] >> 16) : (pk[r >> 1] & 0xffffu); const int kb = crow(r, hi);
                const bool sel = cd >= hiT;
                bits |= sel ? (1u << kb) : 0u;
                if (cd >= loT && !sel) { const unsigned pos = lds_add(&ccntL[r32], 1u); if (pos < (unsigned)IX_CAP) { candC[r32 * IX_CAP + pos] = cd; candI[r32 * IX_CAP + pos] = w * 32 + kb; } } }
            bits |= (unsigned)__shfl_xor((int)bits, 32);
            if (lane < 32) maskL[w * 32 + r32] = bits;
        }
    }
    __syncthreads();
    {   const LAS unsigned* candC2 = (const LAS unsigned*)candS;
        for (int qi = 0; qi < 4; ++qi) { const int q = wave * 4 + qi;
            const int nc = min((int)ccntL[q], IX_CAP), nd = needL[q];
            if (nc == 0 || nd <= 0) continue;
            unsigned key[4]; int kidx[4];
#pragma unroll
            for (int cch = 0; cch < 4; ++cch) { const int p = cch * 64 + lane; const bool valid = p < nc;
                const unsigned cd = valid ? candC2[q * IX_CAP + p] : 0u; kidx[cch] = valid ? candI[q * IX_CAP + p] : 0;
                key[cch] = valid ? (((cd << 13) | (unsigned)(8191 - kidx[cch])) + 1u) : 0u; }
            unsigned thr = 1u;
            if (nc > nd) { thr = 0u;
                for (int bit = 29; bit >= 0; --bit) { const unsigned cand = thr | (1u << bit); int cnt = 0;
#pragma unroll
                    for (int cch = 0; cch < 4; ++cch) cnt += __builtin_popcountll(__ballot(key[cch] >= cand));
                    if (cnt >= nd) thr = cand; } }
#pragma unroll
            for (int cch = 0; cch < 4; ++cch) if (key[cch] >= thr && key[cch] != 0u) __hip_atomic_fetch_or(&maskL[(kidx[cch] >> 5) * 32 + q], 1u << (kidx[cch] & 31), __ATOMIC_RELAXED, __HIP_MEMORY_SCOPE_WORKGROUP);
        }
    }
    __syncthreads();
    unsigned* gm = (unsigned*)(ws + WS_MASK) + ((size_t)b * 16512 + (size_t)ch * (ch + 1)) * 64 + half * 32;
    for (int idx = tid; idx < ntile * 32; idx += 512) gm[(size_t)(idx >> 5) * 64 + (idx & 31)] = maskL[idx];
    __syncthreads();
}
__device__ __forceinline__ void phase2(const Args& a, const Ctx& c) {
    for (int job = c.vcu; job < 512; job += c.G) { const int b = job >> 7, cp = (job >> 1) & 63, half = job & 1;
        indexer_unit(a, c, b, cp, half); indexer_unit(a, c, b, 127 - cp, half); }
}

constexpr int AT_KB = 9216, AT_VOFF = 2 * AT_KB, AT_TR = 73728, AT_TRW = 8704, AT_TSTR = 272;
template <int DV, bool MASKED>
__device__ __forceinline__ void attn_run(const Ctx& c, const bf16_t* Qrow0, const bf16_t* Krow0, const bf16_t* VT, const unsigned* gmask_b, int q0, f32x16 (&o)[DV / 32], float& lsum) {
    LAS unsigned char* lds = c.lds;
    int tid = c.tid; asm volatile("" : "+v"(tid));
    const int lane = tid & 63, wave = c.wave, r32 = lane & 31, hi = lane >> 5;
    constexpr int NV = DV / 64, VB = DV * 144, NPV = DV / 8;
    const int qw0 = q0 + 32 * wave, cw = qw0 >> 6, NTw = cw + 1, NT = (q0 >> 6) + 4;
    bf16x8 qf[4];
#pragma unroll
    for (int ks = 0; ks < 4; ++ks) qf[ks] = *(const GAS bf16x8*)(Qrow0 + (size_t)(32 * wave + r32) * 512 + 16 * ks + 8 * hi);
#pragma unroll
    for (int i = 0; i < DV / 32; ++i) o[i] = (f32x16){0.f, 0.f, 0.f, 0.f, 0.f, 0.f, 0.f, 0.f, 0.f, 0.f, 0.f, 0.f, 0.f, 0.f, 0.f, 0.f};
    float mref = 0.f, lrun = 0.f;
    const bf16x2_t ones2_ = {(__bf16)1.0f, (__bf16)1.0f};
    f32x16 negm = {0.f, 0.f, 0.f, 0.f, 0.f, 0.f, 0.f, 0.f, 0.f, 0.f, 0.f, 0.f, 0.f, 0.f, 0.f, 0.f};
    u32x4 kreg, vreg[NV];
    const int krow = tid >> 3, kch = tid & 7;
    const LAS unsigned char* kfb = lds + r32 * 144 + hi * 16;
    const LAS unsigned char* vfb = lds + AT_VOFF + r32 * 144 + hi * 16;
#define AT_LOADK(t) do { kreg = *(const GAS u32x4*)(Krow0 + (size_t)((t) * 64 + krow) * 512 + kch * 8); } while (0)
#define AT_LOADV(t) do { _Pragma("unroll") for (int _i = 0; _i < NV; ++_i) vreg[_i] = *(const GAS u32x4*)(VT + (size_t)(krow + 64 * _i) * S + (t) * 64 + kch * 8); } while (0)
#define AT_STOREK(bf) do { *(LAS u32x4*)(lds + (bf) * AT_KB + krow * 144 + kch * 16) = kreg; } while (0)
#define AT_STOREV(vi) do { _Pragma("unroll") for (int _i = 0; _i < NV; ++_i) *(LAS u32x4*)(lds + AT_VOFF + (vi) * VB + (krow + 64 * _i) * 144 + kch * 16) = vreg[_i]; } while (0)
#define AT_KF(bf, g) (*(const LAS bf16x8*)(kfb + (bf) * AT_KB + ((g) & 1) * (32 * 144) + ((g) >> 1) * 32))
#define AT_VF(vi, g) (*(const LAS bf16x8*)(vfb + (vi) * VB + ((g) >> 2) * (32 * 144) + ((g) & 3) * 32))
#define AT_SBAR() __builtin_amdgcn_sched_barrier(0)
#define AT_MAX(X0, X1, mx) do { mx = fmaxf(fmaxf(X0[0], X1[0]), fmaxf(X0[1], X1[1])); \
        _Pragma("unroll") for (int r = 2; r < 16; r += 2) mx = fmaxf(fmaxf(mx, X0[r]), fmaxf(X1[r], fmaxf(X0[r + 1], X1[r + 1]))); \
        mx = xmax32(mx); } while (0)
#define AT_EXP4(X0, X1, g) do { _Pragma("unroll") for (int r = 4 * (g); r < 4 * (g) + 4; ++r) { float p0 = __builtin_amdgcn_exp2f(X0[r]), p1 = __builtin_amdgcn_exp2f(X1[r]); \
            if (MASKED) { const int kbit = (r & 3) + 8 * (r >> 2); int m0_, m1_; asm("v_bfe_i32 %0, %1, %2, 1" : "=v"(m0_) : "v"(w0), "n"(kbit)); asm("v_bfe_i32 %0, %1, %2, 1" : "=v"(m1_) : "v"(w1), "n"(kbit)); \
                p0 = __builtin_bit_cast(float, __builtin_bit_cast(int, p0) & m0_); p1 = __builtin_bit_cast(float, __builtin_bit_cast(int, p1) & m1_); } \
            X0[r] = p0; X1[r] = p1; } } while (0)
    AT_LOADK(0); AT_STOREK(0); AT_LOADV(0); AT_STOREV(0); AT_LOADK(1); AT_STOREK(1);
    __syncthreads();
    const unsigned* mrow = MASKED ? gmask_b + ((size_t)cw * (cw + 1)) * 64 + (qw0 & 63) + r32 : nullptr;
    f32x16 pa0, pa1, pb0, pb1;
    bf16x8 pk[2][2];
    int w0 = -1, w1 = -1;
    {
#pragma unroll
        for (int g = 0; g < 8; ++g) { const bf16x8 kf = AT_KF(0, g);
            if (g & 1) pa1 = __builtin_amdgcn_mfma_f32_32x32x16_bf16(kf, qf[g >> 1], g < 2 ? negm : pa1, 0, 0, 0); else pa0 = __builtin_amdgcn_mfma_f32_32x32x16_bf16(kf, qf[g >> 1], g < 2 ? negm : pa0, 0, 0, 0); }
        float mx; AT_MAX(pa0, pa1, mx); mref = mx;
#pragma unroll
        for (int r = 0; r < 16; ++r) { negm[r] = -mref; pa0[r] -= mref; pa1[r] -= mref; }
        if (MASKED) { w0 = (int)(mrow[0] >> (4 * hi)); w1 = (int)(mrow[64] >> (4 * hi)); }
#pragma unroll
        for (int g = 0; g < 4; ++g) AT_EXP4(pa0, pa1, g);
    }
    __syncthreads();
#define AT_STEP(t, Y0, Y1, X0, X1) do { \
        const int kb_ = (t) & 1, vb_ = ((t) - 1) & 1; \
        if ((t) + 1 < NT) AT_LOADK((t) + 1); \
        if ((t) < NT) AT_LOADV(t); \
        if ((t) <= NTw) {                               \
            float sacc = 0.f, fres = 1.f; \
            if (MASKED) { w0 = (int)(mrow[(size_t)(2 * (t)) * 64] >> (4 * hi)); w1 = (int)(mrow[(size_t)(2 * (t) + 1) * 64] >> (4 * hi)); } \
              \
            bf16x8 kfr[8]; kfr[0] = AT_KF(kb_, 0); kfr[1] = AT_KF(kb_, 1); \
            AT_SBAR(); \
            _Pragma("unroll") for (int g = 0; g < 8; ++g) { if (g + 2 < 8) kfr[g + 2] = AT_KF(kb_, g + 2); const bf16x8 kf = kfr[g]; \
                if (g & 1) X1 = __builtin_amdgcn_mfma_f32_32x32x16_bf16(kf, qf[g >> 1], g < 2 ? negm : X1, 0, 0, 0); else X0 = __builtin_amdgcn_mfma_f32_32x32x16_bf16(kf, qf[g >> 1], g < 2 ? negm : X0, 0, 0, 0); \
                  \
                { const int s_ = g >> 2, j_ = g & 3; unsigned a_ = pk2(Y0[2 * g], Y0[2 * g + 1]), b_ = pk2(Y1[2 * g], Y1[2 * g + 1]); \
                  sacc = __builtin_amdgcn_fdot2_f32_bf16(__builtin_bit_cast(bf16x2_t, a_), ones2_, sacc, false); sacc = __builtin_amdgcn_fdot2_f32_bf16(__builtin_bit_cast(bf16x2_t, b_), ones2_, sacc, false);     \
                  u32x4 t0_ = __builtin_bit_cast(u32x4, pk[0][s_]), t1_ = __builtin_bit_cast(u32x4, pk[1][s_]); t0_[j_] = a_; t1_[j_] = b_; pk[0][s_] = __builtin_bit_cast(bf16x8, t0_); pk[1][s_] = __builtin_bit_cast(bf16x8, t1_); } \
                AT_SBAR(); } \
            lrun += sacc; \
              \
            float dl; { const float tot_ = xsum32(sacc);     \
              dl = (tot_ > 65536.f && tot_ < 1.0e30f) ? (float)((int)(__builtin_bit_cast(unsigned, tot_) >> 23) - 127) : 0.f; }     \
            if (__any(dl != 0.f)) { mref += dl; fres = __builtin_amdgcn_exp2f(-dl); lrun *= fres; \
                _Pragma("unroll") for (int r = 0; r < 16; ++r) { X0[r] -= dl; X1[r] -= dl; negm[r] = -mref; } } \
              \
            bf16x8 vfr[NPV]; vfr[0] = AT_VF(vb_, 0); vfr[1] = AT_VF(vb_, 1); \
            AT_SBAR(); \
            _Pragma("unroll") for (int g = 0; g < NPV; ++g) { if (g + 2 < NPV) vfr[g + 2] = AT_VF(vb_, g + 2); \
                o[g >> 2] = __builtin_amdgcn_mfma_f32_32x32x16_bf16(vfr[g], pk[(g >> 1) & 1][g & 1], o[g >> 2], 0, 0, 0); \
                if (NPV == 16) { if (!(g & 3)) AT_EXP4(X0, X1, g >> 2); } else { if (!(g & 1)) AT_EXP4(X0, X1, g >> 1); } \
                AT_SBAR(); } \
            if (__any(fres != 1.f)) { _Pragma("unroll") for (int i = 0; i < DV / 32; ++i) o[i] = o[i] * fres; }     \
        } \
        if ((t) + 1 < NT) AT_STOREK(((t) + 1) & 1); \
        if ((t) < NT) AT_STOREV((t) & 1); \
        __syncthreads(); \
    } while (0)
#pragma unroll 1
    for (int t = 1; t <= NT; t += 2) { AT_STEP(t, pa0, pa1, pb0, pb1); if (t + 1 <= NT) AT_STEP(t + 1, pb0, pb1, pa0, pa1); }
#undef AT_STEP
#undef AT_EXP4
#undef AT_MAX
#undef AT_SBAR
#undef AT_KF
#undef AT_VF
#undef AT_LOADK
#undef AT_LOADV
#undef AT_STOREK
#undef AT_STOREV
    lsum = lrun + __shfl_xor(lrun, 32);
}
template <int DV>
__device__ __forceinline__ void attn_store(const Ctx& c, const f32x16 (&v)[DV / 32], bf16_t* dst) {
    LAS unsigned char* tb = c.lds + AT_TR + c.wave * AT_TRW;
    int lane = c.lane; asm volatile("" : "+v"(lane));
    const int r32 = lane & 31, hi = lane >> 5;
#pragma unroll
    for (int i = 0; i < DV / 32; ++i)
#pragma unroll
        for (int g = 0; g < 4; ++g) { u32x2 w; w.x = pk2(v[i][4 * g], v[i][4 * g + 1]); w.y = pk2(v[i][4 * g + 2], v[i][4 * g + 3]);
            *(LAS u32x2*)(tb + r32 * AT_TSTR + (32 * i + 8 * g + 4 * hi) * 2) = w; }
    LDS_WAIT(); asm volatile("" ::: "memory");
    constexpr int CPR = DV / 8;
#pragma unroll
    for (int k = 0; k < DV / 16; ++k) { const int idx = lane + 64 * k, row = idx / CPR, ch = idx % CPR;
        *(GAS u32x4*)(dst + (size_t)row * D + ch * 8) = *(const LAS u32x4*)(tb + row * AT_TSTR + ch * 16); }
    LDS_WAIT(); asm volatile("" ::: "memory");
}
__device__ __forceinline__ void attn_unit_A(const Args& a, const Ctx& c, int b, int head, int qblk) {
    unsigned char* ws = a.ws; const int q0 = qblk * 256;
    f32x16 o[2]; float l;
    attn_run<64, true>(c, (const bf16_t*)(ws + WS_AQ) + (size_t)(b * S + q0) * 512 + head * 64, (const bf16_t*)(ws + WS_AK) + (size_t)b * S * 512 + head * 64,
                       (const bf16_t*)(ws + WS_AVT) + (size_t)(b * 8 + head) * 64 * S, (const unsigned*)(ws + WS_MASK) + (size_t)b * 16512 * 64, q0, o, l);
    const float il = l > 0.f ? 1.f / l : 0.f;
    o[0] = o[0] * il; o[1] = o[1] * il;
    attn_store<64>(c, o, (bf16_t*)(ws + WS_AO) + (size_t)(b * S + q0 + 32 * c.wave) * D + head * 64);
}
__device__ __forceinline__ void attn_unit_B(const Args& a, const Ctx& c, int b, int head, int qblk, float lam) {
    unsigned char* ws = a.ws; const int q0 = qblk * 256; int lane = c.lane; asm volatile("" : "+v"(lane)); const int hi = lane >> 5;
    float* st = (float*)(ws + WS_STASH) + ((size_t)(blockIdx.x * 8 + c.wave) * 64 + lane) * 64;
    const bf16_t* VT = (const bf16_t*)(ws + WS_BVT) + (size_t)(b * 4 + head) * 128 * S;
    {   f32x16 o1[4]; float l1;
        attn_run<128, false>(c, (const bf16_t*)(ws + WS_BQ) + (size_t)(b * S + q0) * 512 + (2 * head) * 64, (const bf16_t*)(ws + WS_BK) + (size_t)b * S * 512 + (2 * head) * 64, VT, nullptr, q0, o1, l1);
        const float il = l1 > 0.f ? 1.f / l1 : 0.f;
#pragma unroll
        for (int i = 0; i < 4; ++i)
#pragma unroll
            for (int g = 0; g < 4; ++g) *(GAS f32x4*)(st + i * 16 + 4 * g) = (f32x4){o1[i][4 * g], o1[i][4 * g + 1], o1[i][4 * g + 2], o1[i][4 * g + 3]} * il;
    }
    f32x16 o2[4]; float l2;
    attn_run<128, false>(c, (const bf16_t*)(ws + WS_BQ) + (size_t)(b * S + q0) * 512 + (2 * head + 1) * 64, (const bf16_t*)(ws + WS_BK) + (size_t)b * S * 512 + (2 * head + 1) * 64, VT, nullptr, q0, o2, l2);
    const float il2 = l2 > 0.f ? lam / l2 : 0.f; float ss = 0.f;
#pragma unroll
    for (int i = 0; i < 4; ++i)
#pragma unroll
        for (int g = 0; g < 4; ++g) { const f32x4 sv = *(const GAS f32x4*)(st + i * 16 + 4 * g);
#pragma unroll
            for (int j = 0; j < 4; ++j) { const float d = sv[j] - o2[i][4 * g + j] * il2; o2[i][4 * g + j] = d; ss += d * d; } }
    ss += __shfl_xor(ss, 32);
    const float rr = (1.f / sqrtf(ss * (1.f / 128.f) + RMS_EPS)) * (1.f - LAMBDA_INIT);
#pragma unroll
    for (int i = 0; i < 4; ++i)
#pragma unroll
        for (int g = 0; g < 4; ++g) { const f32x4 gg = *(const GAS f32x4*)(a.subln_g + 32 * i + 8 * g + 4 * hi);
#pragma unroll
            for (int j = 0; j < 4; ++j) o2[i][4 * g + j] = o2[i][4 * g + j] * rr * gg[j]; }
    attn_store<128>(c, o2, (bf16_t*)(ws + WS_AO) + (size_t)(b * S + q0 + 32 * c.wave) * D + 512 + head * 128);
}
__device__ __forceinline__ void phase3(const Args& a, const Ctx& c) {
    float lam;
    { const float p1 = a.lq1[c.lane] * a.lk1[c.lane], p2 = a.lq2[c.lane] * a.lk2[c.lane]; lam = expf(wave_sum(p1)) - expf(wave_sum(p2)) + LAMBDA_INIT; }
    for (int job = c.vcu; job < 768; job += c.G) {
        if (job < 256) { const int b = job >> 6, head = (job >> 4) & 3, j = job & 15; attn_unit_B(a, c, b, head, j, lam); attn_unit_B(a, c, b, head, 31 - j, lam); }
        else { const int p = job - 256, b = p >> 7, head = (p >> 4) & 7, j = p & 15; attn_unit_A(a, c, b, head, j); attn_unit_A(a, c, b, head, 31 - j); }
    }
}

struct EpiY1 {
    const float* x; const float* st; const float* g; const float* bb; float* y1; f32x2* yst;
    __device__ __forceinline__ void operator()(const f32x4 (&acc)[2][2][4][2], const pg8::Unit& u, int wr, int wc, int fr, int fq) const {
        const int pm = u.i0, pn = u.i1; const int col0 = pn * 256 + 32 * wc + 4 * fq;
        f32x4 gv[2][2], bv[2][2];
#pragma unroll
        for (int bj = 0; bj < 2; ++bj)
#pragma unroll
            for (int n = 0; n < 2; ++n) { gv[bj][n] = *(const GAS f32x4*)(g + col0 + 128 * bj + 16 * n); bv[bj][n] = *(const GAS f32x4*)(bb + col0 + 128 * bj + 16 * n); }
#pragma unroll
        for (int ai = 0; ai < 2; ++ai)
#pragma unroll
            for (int m = 0; m < 4; ++m) { const int row = pm * 256 + 128 * ai + 64 * wr + 16 * m + fr;
                const f32x2 ms = *(const GAS f32x2*)(st + 2 * row);
                f32x4 xv[2][2];
#pragma unroll
                for (int bj = 0; bj < 2; ++bj)
#pragma unroll
                    for (int n = 0; n < 2; ++n) xv[bj][n] = *(const GAS f32x4*)(x + (size_t)row * D + col0 + 128 * bj + 16 * n);
                f32x4 s4 = {0.f, 0.f, 0.f, 0.f}, q4 = {0.f, 0.f, 0.f, 0.f};
#pragma unroll
                for (int bj = 0; bj < 2; ++bj)
#pragma unroll
                    for (int n = 0; n < 2; ++n) { const f32x4 yv = ((xv[bj][n] - ms.x) * ms.y * gv[bj][n] + bv[bj][n]) * ALPHA + acc[ai][bj][m][n]; s4 += yv; q4 += yv * yv;
                        *(GAS f32x4*)(y1 + (size_t)row * D + col0 + 128 * bj + 16 * n) = yv; }
                float sv = (s4.x + s4.y) + (s4.z + s4.w), qv = (q4.x + q4.y) + (q4.z + q4.w);
                sv = xsum32(xsum16(sv)); qv = xsum32(xsum16(qv));
                if (fq == 0) yst[(size_t)row * 16 + pn * 4 + wc] = (f32x2){sv, qv}; }
    }
};
__device__ __forceinline__ void phase4(const Args& a, const Ctx& c) {
    pg8::DenseOrder S1; S1.init(a.ws + WS_WO, T, D, D, c.G, (int)blockIdx.x);
    EpiY1 E{a.x, (const float*)(a.ws + WS_STATS0), a.ln_emb_g, a.ln_emb_b, (float*)(a.ws + WS_Y1), (f32x2*)(a.ws + WS_YST)};
    pg8::gemm_phase(c.lds, (const char*)(a.ws + WS_AO), D, S1, E);
    { pg8::DenseOrder S2; S2.init(a.ws + WS_WPP, T, D, 256, c.G, (int)blockIdx.x); EpiBf16 E2{(bf16_t*)(a.ws + WS_PP)};
      pg8::gemm_phase<EpiBf16, pg8::DenseOrder, true>(c.lds, (const char*)(a.ws + WS_PB), 256, S2, E2); }
}

constexpr int P5_HSTR = 132;
constexpr int P5_W = 128 * P5_HSTR * 4, P5_STATS = P5_W + 32768, P5_CNT = P5_STATS + 1024;
__device__ __forceinline__ void phase5(const Args& a, const Ctx& c) {
    unsigned char* ws = a.ws; LAS unsigned char* lds = c.lds; const int tid = c.tid, lane = c.lane, wave = c.wave;
    LAS float* hsL = (LAS float*)lds; LAS float* wL = (LAS float*)(lds + P5_W); LAS float* statsL = (LAS float*)(lds + P5_STATS); LAS float* logitL = (LAS float*)lds; LAS unsigned* cntL = (LAS unsigned*)(lds + P5_CNT);
    const float* y1 = (const float*)(ws + WS_Y1);
    for (int tb = c.vcu; tb < 256; tb += c.G) {
        const int m0 = tb * 128;
        if (lane < 16) {
            const int row = wave * 16 + lane; const f32x4* pp = (const f32x4*)((const f32x2*)(ws + WS_YST) + (size_t)(m0 + row) * 16);
            float sm = 0.f, sq = 0.f;
#pragma unroll
            for (int i = 0; i < 8; ++i) { const f32x4 v = pp[i]; sm += v.x; sq += v.y; sm += v.z; sq += v.w; }
            const float mean = sm * (1.f / D), var = fmaxf(sq * (1.f / D) - mean * mean, 0.f);
            statsL[2 * row] = mean; statsL[2 * row + 1] = 1.f / sqrtf(var + LN_EPS); }
        if (tid < 64) cntL[tid] = 0u;
        __syncthreads();
        const int tg = wave >> 1, et = wave & 1, r32 = lane & 31, hi = lane >> 5;
        f32x16 acc = {0.f, 0.f, 0.f, 0.f, 0.f, 0.f, 0.f, 0.f, 0.f, 0.f, 0.f, 0.f, 0.f, 0.f, 0.f, 0.f};
        const float* yw = y1 + (size_t)(m0 + wave * 16) * D + 2 * lane;
        bf16_t* hw = (bf16_t*)(ws + WS_H1B) + (size_t)(m0 + wave * 16) * D + 2 * lane;
        const float* wsrc = (const float*)(ws + WS_WRP) + 4 * tid;
        const LAS float* aL = hsL + (32 * tg + r32) * P5_HSTR + 4 * hi;
        const LAS float* bL = wL + ((et * 16) * 2 + hi) * 128 + 4 * r32;
        float mean16[16], rstd16[16];
#pragma unroll
        for (int r = 0; r < 16; ++r) { mean16[r] = statsL[2 * (wave * 16 + r)]; rstd16[r] = statsL[2 * (wave * 16 + r) + 1]; }
        f32x2 yv[16]; f32x4 wq[4];
#pragma unroll
        for (int r = 0; r < 16; ++r) yv[r] = *(const GAS f32x2*)(yw + (size_t)r * D);
#pragma unroll
        for (int q = 0; q < 4; ++q) wq[q] = *(const GAS f32x4*)(wsrc + 2048 * q);
#pragma unroll 1
        for (int sl = 0; sl < 8; ++sl) {
            const f32x2 gv = *(const GAS f32x2*)(a.ln1_g + 128 * sl + 2 * lane), bv = *(const GAS f32x2*)(a.ln1_b + 128 * sl + 2 * lane);
#pragma unroll
            for (int r = 0; r < 16; ++r) { const f32x2 h = (yv[r] - mean16[r]) * rstd16[r] * gv + bv;
                *(LAS f32x2*)(hsL + (wave * 16 + r) * P5_HSTR + 2 * lane) = h; *(GAS unsigned*)(hw + (size_t)r * D + 128 * sl) = pk2(h.x, h.y); }
#pragma unroll
            for (int q = 0; q < 4; ++q) *(LAS f32x4*)(wL + 4 * tid + 2048 * q) = wq[q];
            if (sl < 7) {
#pragma unroll
                for (int r = 0; r < 16; ++r) yv[r] = *(const GAS f32x2*)(yw + (size_t)r * D + 128 * (sl + 1));
#pragma unroll
                for (int q = 0; q < 4; ++q) wq[q] = *(const GAS f32x4*)(wsrc + 8192 * (sl + 1) + 2048 * q); }
            __syncthreads();
            f32x4 av[2][4], bw[2][4];
#pragma unroll
            for (int q = 0; q < 4; ++q) { av[0][q] = *(const LAS f32x4*)(aL + 8 * q); bw[0][q] = *(const LAS f32x4*)(bL + 256 * q); }
#pragma unroll
            for (int bt = 0; bt < 4; ++bt) {
                if (bt < 3) {
#pragma unroll
                    for (int q = 0; q < 4; ++q) { av[(bt + 1) & 1][q] = *(const LAS f32x4*)(aL + 8 * (4 * (bt + 1) + q)); bw[(bt + 1) & 1][q] = *(const LAS f32x4*)(bL + 256 * (4 * (bt + 1) + q)); } }
#pragma unroll
                for (int q = 0; q < 4; ++q)
#pragma unroll
                    for (int jj = 0; jj < 4; ++jj) acc = __builtin_amdgcn_mfma_f32_32x32x2f32(av[bt & 1][q][jj], bw[bt & 1][q][jj], acc, 0, 0, 0);
                __builtin_amdgcn_sched_barrier(0);
            }
            __syncthreads();
        }
#pragma unroll
        for (int r = 0; r < 16; ++r) logitL[(32 * tg + crow(r, hi)) * 65 + 32 * et + r32] = acc[r];
        __syncthreads();
        if (wave < 2) {
            const int tok = wave * 64 + lane, m = m0 + tok;
            LAS float* row = logitL + tok * 65; LAS float* srow = logitL + 128 * 65 + tok * 65;
#pragma unroll 8
            for (int e = 0; e < 64; ++e) { const float sg = 1.f / (1.f + expf(-row[e])); srow[e] = sg; row[e] = sg + a.router_bias[e]; }
            float gs[8];
#pragma unroll
            for (int g = 0; g < 8; ++g) { float v[8];
#pragma unroll
                for (int j = 0; j < 8; ++j) v[j] = row[8 * g + j];
                const float m1 = fmaxf(fmaxf(fmaxf(v[0], v[1]), fmaxf(v[2], v[3])), fmaxf(fmaxf(v[4], v[5]), fmaxf(v[6], v[7])));
                float m2 = -INFINITY; bool seen = false;
#pragma unroll
                for (int j = 0; j < 8; ++j) { const bool is = (v[j] == m1) && !seen; seen = seen || is; m2 = is ? m2 : fmaxf(m2, v[j]); }
                gs[g] = m1 + m2; }
#pragma unroll
            for (int g = 0; g < 8; ++g) { int rk = 0;
#pragma unroll
                for (int g2 = 0; g2 < 8; ++g2) rk += (gs[g2] > gs[g] || (gs[g2] == gs[g] && g2 < g)) ? 1 : 0;
                if (rk >= 4) {
#pragma unroll
                    for (int j = 0; j < 8; ++j) row[8 * g + j] = -INFINITY; } }
            int sel[8]; float sv[8]; float ssum = 0.f;
#pragma unroll
            for (int k = 0; k < 8; ++k) { float best = -INFINITY; int bi = 0;
#pragma unroll 8
                for (int e = 0; e < 64; ++e) { const float v = row[e]; if (v > best) { best = v; bi = e; } }
                sel[k] = bi; sv[k] = srow[bi]; ssum += sv[k]; row[bi] = -INFINITY; }
            typedef int i32x4 __attribute__((ext_vector_type(4)));
            *(GAS i32x4*)((int*)(ws + WS_EIDX) + (size_t)m * 8) = (i32x4){sel[0], sel[1], sel[2], sel[3]}; *(GAS i32x4*)((int*)(ws + WS_EIDX) + (size_t)m * 8 + 4) = (i32x4){sel[4], sel[5], sel[6], sel[7]};
            f32x4 g0, g1;
#pragma unroll
            for (int k = 0; k < 4; ++k) { g0[k] = sv[k] / ssum * 2.5f; g1[k] = sv[4 + k] / ssum * 2.5f; }
            *(GAS f32x4*)((float*)(ws + WS_GATE) + (size_t)m * 8) = g0; *(GAS f32x4*)((float*)(ws + WS_GATE) + (size_t)m * 8 + 4) = g1;
#pragma unroll
            for (int k = 0; k < 8; ++k) lds_add(&cntL[sel[k]], 1u);
        }
        __syncthreads();
        if (tid < 64) ((unsigned*)(ws + WS_CNTWG))[tb * 64 + tid] = cntL[tid];
        __syncthreads();
    }
}

__device__ __forceinline__ void phase6(const Args& a, const Ctx& c) {
    unsigned char* ws = a.ws; const int tid = c.tid, lane = c.lane;
    LAS unsigned* baseL = (LAS unsigned*)c.lds;
    const unsigned* cntwg = (const unsigned*)(ws + WS_CNTWG);
    for (int tb = c.vcu; tb < 256; tb += c.G) {
        const int r = tb / TBR;
        int* tab = (int*)(ws + WS_TABLES) + r * 240;
        int* tokbuf = (int*)(ws + WS_TOKBUF) + (size_t)r * (RROWS + 256); float* gwbuf = (float*)(ws + WS_GWBUF) + (size_t)r * (RROWS + 256);
        {
            const int e = tid & 63, part = tid >> 6; int tot = 0, pre = 0; unsigned cv[TBR / 8];
#pragma unroll
            for (int j = 0; j < TBR / 8; ++j) cv[j] = cntwg[(r * TBR + part * (TBR / 8) + j) * 64 + e];
#pragma unroll
            for (int j = 0; j < TBR / 8; ++j) { tot += (int)cv[j]; if (r * TBR + part * (TBR / 8) + j < tb) pre += (int)cv[j]; }
            baseL[64 + tid] = (unsigned)tot; baseL[64 + 512 + tid] = (unsigned)pre;
        }
        __syncthreads();
        if (tid < 64) { const int e = tid; int tot = 0, pre = 0;
#pragma unroll
            for (int p8 = 0; p8 < 8; ++p8) { tot += (int)baseL[64 + 64 * p8 + e]; pre += (int)baseL[64 + 512 + 64 * p8 + e]; }
            int incl = tot, nt = (tot + 255) >> 8, incl2 = nt;
#pragma unroll
            for (int o = 1; o < 64; o <<= 1) { const int t1 = __shfl_up(incl, o), t2 = __shfl_up(incl2, o); if (lane >= o) { incl += t1; incl2 += t2; } }
            baseL[e] = (unsigned)(incl - tot + pre);
            if ((tb % TBR) == 0) { tab[e] = tot; tab[80 + e] = incl - tot; tab[160 + e] = incl2 - nt;
                if (e == 63) { tab[64] = RT; tab[80 + 64] = RROUTED; tab[160 + 64] = incl2; tab[160 + 65] = incl2 + RT / 256; } }
        }
        __syncthreads();
        for (int ai = tid; ai < 1024; ai += 512) { const int tok = tb * 128 + (ai >> 3), k = ai & 7;
            const int e = ((const int*)(ws + WS_EIDX))[(size_t)tok * 8 + k]; const unsigned slot = lds_add(&baseL[e], 1u);
            tokbuf[slot] = tok; gwbuf[slot] = ((const float*)(ws + WS_GATE))[(size_t)tok * 8 + k]; ((int*)(ws + WS_SLOTOF))[(size_t)tok * 8 + k] = (int)slot; }
        if (tid < 128) { const int tok = tb * 128 + tid; const int slot = RROUTED + (tok % RT); tokbuf[slot] = tok; gwbuf[slot] = 1.f; }
        if ((tb % TBR) == 0 && tid < 256) { tokbuf[RROWS + tid] = 0; gwbuf[RROWS + tid] = 0.f; }
        __syncthreads();
    }
}

struct GroupOrder {
    const LAS int* tab; const char* Wbase; size_t wstride; int NPN, G, c, K; const int* tok;
    __device__ __forceinline__ bool next(int i, pg8::Unit& u) const {
        const int L = i * G + c; if (L >= tab[160 + 65] * NPN) return false;
        const int tau = L / NPN, pn = L % NPN; int lo = 0, hi = 64;
        while (lo < hi) { const int mid = (lo + hi + 1) >> 1; if (tab[160 + mid] <= tau) lo = mid; else hi = mid - 1; }
        const int e = lo, j = tau - tab[160 + e];
        u.bt = Wbase + (size_t)e * wstride + (size_t)pn * 256 * K * 2; u.arow = tab[80 + e] + 256 * j; u.i0 = e; u.i1 = pn; const int rem = tab[e] - 256 * j; u.i2 = rem < 256 ? rem : 256; return true;
    }
    __device__ __forceinline__ void aoffs(const pg8::Unit& u, const int (&R)[2], const int (&C)[2], int K_, unsigned (&o0)[2], unsigned (&o1)[2]) const {
#pragma unroll
        for (int i = 0; i < 2; ++i) { int r0 = u.arow + R[i], r1 = r0 + 128; if (tok) { r0 = tok[r0]; r1 = tok[r1]; }
            o0[i] = (unsigned)(r0 * K_ + C[i]) * 2u; o1[i] = (unsigned)(r1 * K_ + C[i]) * 2u; }
    }
};
struct EpiHid {
    bf16_t* hid;
    __device__ __forceinline__ void operator()(const f32x4 (&acc)[2][2][4][2], const pg8::Unit& u, int wr, int wc, int fr, int fq) const {
        const int pn = u.i1, lim = u.i2;
#pragma unroll
        for (int ai = 0; ai < 2; ++ai)
#pragma unroll
            for (int m = 0; m < 4; ++m) { const int row = 128 * ai + 64 * wr + 16 * m + fr;
                if (row < lim) {
#pragma unroll
                    for (int bj = 0; bj < 2; ++bj) { const f32x4 g = acc[ai][bj][m][0], uu = acc[ai][bj][m][1]; f32x4 h;
#pragma unroll
                        for (int i = 0; i < 4; ++i) h[i] = g[i] * __builtin_amdgcn_rcpf(1.f + __expf(-g[i])) * uu[i];
                        u32x2 w; w.x = pk2(h[0], h[1]); w.y = pk2(h[2], h[3]);
                        *(GAS u32x2*)(hid + (size_t)(u.arow + row) * 256 + 128 * pn + 64 * bj + 16 * wc + 4 * fq) = w; } } }
    }
};
struct EpiSlot {
    bf16_t* slots; bf16_t* slots_sh; const float* gw;
    __device__ __forceinline__ void operator()(const f32x4 (&acc)[2][2][4][2], const pg8::Unit& u, int wr, int wc, int fr, int fq) const {
        const int pn = u.i1, lim = u.i2; bf16_t* const sb = u.i0 == NE ? slots_sh : slots;
        float wgt[2][4];
#pragma unroll
        for (int ai = 0; ai < 2; ++ai)
#pragma unroll
            for (int m = 0; m < 4; ++m) wgt[ai][m] = gw[u.arow + 128 * ai + 64 * wr + 16 * m + fr];
#pragma unroll
        for (int ai = 0; ai < 2; ++ai)
#pragma unroll
            for (int m = 0; m < 4; ++m) { const int row = 128 * ai + 64 * wr + 16 * m + fr;
                if (row < lim) {
#pragma unroll
                    for (int bj = 0; bj < 2; ++bj) { const f32x4 v0 = acc[ai][bj][m][0] * wgt[ai][m], v1 = acc[ai][bj][m][1] * wgt[ai][m]; u32x4 w; w.x = pk2(v0[0], v0[1]); w.y = pk2(v0[2], v0[3]); w.z = pk2(v1[0], v1[1]); w.w = pk2(v1[2], v1[3]);
                        *(GAS u32x4*)(sb + (size_t)(u.arow + row) * D + pn * 256 + 128 * bj + 32 * wc + 8 * fq) = w; } } }
    }
};
__device__ __forceinline__ void load_tab(const Args& a, const Ctx& c, int r) {
    LAS int* tabL = (LAS int*)(c.lds + MISC_OFF + 256);
    __syncthreads();
    if (c.tid < 240) tabL[c.tid] = ((const int*)(a.ws + WS_TABLES))[r * 240 + c.tid];
    __syncthreads();
}
__device__ __forceinline__ void phase7(const Args& a, const Ctx& c, int r) {
    load_tab(a, c, r);
    GroupOrder S1{(const LAS int*)(c.lds + MISC_OFF + 256), (const char*)(a.ws + WS_WGU), (size_t)512 * D * 2, 2, c.G, c.vcu, D, (const int*)(a.ws + WS_TOKBUF) + (size_t)r * (RROWS + 256)};
    EpiHid E{(bf16_t*)((unsigned char*)a.out + OUT_HID)};
    pg8::gemm_phase(c.lds, (const char*)(a.ws + WS_H1B), D, S1, E);
}
__device__ __forceinline__ void phase8(const Args& a, const Ctx& c, int r) {
    load_tab(a, c, r);
    GroupOrder S1{(const LAS int*)(c.lds + MISC_OFF + 256), (const char*)(a.ws + WS_WD), (size_t)D * 256 * 2, 4, c.G, c.vcu, 256, nullptr};
    EpiSlot E{(bf16_t*)(a.ws + WS_SLOTS), (bf16_t*)((unsigned char*)a.out + OUT_SLOTS_SH) - (size_t)RROUTED * D, (const float*)(a.ws + WS_GWBUF) + (size_t)r * (RROWS + 256)};
    pg8::gemm_phase<EpiSlot, GroupOrder, true>(c.lds, (const char*)a.out + OUT_HID, 256, S1, E);
}
__device__ __forceinline__ void phase9(const Args& a, const Ctx& c, int r) {
    unsigned char* ws = a.ws; const int lane = c.lane; const int gw = c.vcu * 8 + c.wave, NGW = c.G * 8;
    const bf16_t* slots = (const bf16_t*)(ws + WS_SLOTS);
    const bf16_t* slots_sh = (const bf16_t*)((const unsigned char*)a.out + OUT_SLOTS_SH);
    for (int mi = gw; mi < RT; mi += NGW) { const int m = r * RT + mi;
        int sl[9];
        { const int* so = (const int*)(ws + WS_SLOTOF) + (size_t)m * 8;
#pragma unroll
          for (int k = 0; k < 8; ++k) sl[k] = so[k];
          sl[8] = mi; }
        f32x4 v[4];
        bf16_t* hrow = (bf16_t*)(ws + WS_H1B) + (size_t)m * D;
#pragma unroll
        for (int j = 0; j < 4; ++j) { const u32x2 hw = *((const GAS u32x2*)hrow + lane + 64 * j);
            v[j][0] = ALPHA * __builtin_bit_cast(float, hw.x << 16); v[j][1] = ALPHA * __builtin_bit_cast(float, hw.x & 0xffff0000u);
            v[j][2] = ALPHA * __builtin_bit_cast(float, hw.y << 16); v[j][3] = ALPHA * __builtin_bit_cast(float, hw.y & 0xffff0000u); }
#pragma unroll
        for (int k = 0; k < 9; ++k) { const GAS u32x2* sr = (const GAS u32x2*)((k == 8 ? slots_sh : slots) + (size_t)sl[k] * D) + lane;
#pragma unroll
            for (int j = 0; j < 4; ++j) { const u32x2 w = sr[64 * j];
                v[j][0] += __builtin_bit_cast(float, w.x << 16); v[j][1] += __builtin_bit_cast(float, w.x & 0xffff0000u);
                v[j][2] += __builtin_bit_cast(float, w.y << 16); v[j][3] += __builtin_bit_cast(float, w.y & 0xffff0000u); } }
        float s = 0.f;
#pragma unroll
        for (int j = 0; j < 4; ++j) s += (v[j].x + v[j].y) + (v[j].z + v[j].w);
        const float mean = wave_sum(s) * (1.f / D); float s2 = 0.f;
#pragma unroll
        for (int j = 0; j < 4; ++j) { const f32x4 d = v[j] - mean; s2 += (d.x * d.x + d.y * d.y) + (d.z * d.z + d.w * d.w); }
        const float rstd = 1.f / sqrtf(wave_sum(s2) * (1.f / D) + LN_EPS);
#pragma unroll
        for (int j = 0; j < 4; ++j) { const f32x4 gg = *((const GAS f32x4*)a.ln2_g + lane + 64 * j), b4 = *((const GAS f32x4*)a.ln2_b + lane + 64 * j); v[j] = (v[j] - mean) * rstd * gg + b4;
 }
        store_row_bf16(hrow, lane, v);
    }
}
struct EpiFinal {
    const bf16_t* h2b; const bf16_t* pp; const float* bias; float* out;
    __device__ __forceinline__ void operator()(const f32x4 (&acc)[2][2][4][2], const pg8::Unit& u, int wr, int wc, int fr, int fq) const {
        const int pm = u.i0, pn = u.i1; const int col0 = pn * 256 + 32 * wc + 4 * fq;
        f32x4 bv[2][2];
#pragma unroll
        for (int bj = 0; bj < 2; ++bj)
#pragma unroll
            for (int n = 0; n < 2; ++n) bv[bj][n] = *(const GAS f32x4*)(bias + col0 + 128 * bj + 16 * n);
#pragma unroll
        for (int ai = 0; ai < 2; ++ai)
#pragma unroll
            for (int m = 0; m < 4; ++m) { const size_t rowoff = (size_t)(pm * 256 + 128 * ai + 64 * wr + 16 * m + fr) * D + col0;
                u32x2 pw[2][2], hw[2][2];
#pragma unroll
                for (int bj = 0; bj < 2; ++bj)
#pragma unroll
                    for (int n = 0; n < 2; ++n) { pw[bj][n] = *(const GAS u32x2*)(pp + rowoff + 128 * bj + 16 * n); hw[bj][n] = *(const GAS u32x2*)(h2b + rowoff + 128 * bj + 16 * n); }
#pragma unroll
                for (int bj = 0; bj < 2; ++bj)
#pragma unroll
                    for (int n = 0; n < 2; ++n) { const f32x4 z = acc[ai][bj][m][n] + bv[bj][n]; const u32x2 p_ = pw[bj][n], h_ = hw[bj][n];
                        const float pf[4] = {__builtin_bit_cast(float, p_.x << 16), __builtin_bit_cast(float, p_.x & 0xffff0000u), __builtin_bit_cast(float, p_.y << 16), __builtin_bit_cast(float, p_.y & 0xffff0000u)};
                        const float hf[4] = {__builtin_bit_cast(float, h_.x << 16), __builtin_bit_cast(float, h_.x & 0xffff0000u), __builtin_bit_cast(float, h_.y << 16), __builtin_bit_cast(float, h_.y & 0xffff0000u)};
                        f32x4 o;
#pragma unroll
                        for (int i = 0; i < 4; ++i) o[i] = hf[i] + pf[i] * __builtin_amdgcn_rcpf(1.f + __expf(-z[i]));
                        __builtin_nontemporal_store(o, (f32x4*)(out + rowoff + 128 * bj + 16 * n)); } }
    }
};
__device__ __forceinline__ void phase10(const Args& a, const Ctx& c) {
    pg8::DenseOrder S1; S1.init(a.ws + WS_WPG, T, D, D, c.G, (int)blockIdx.x);
    EpiFinal E{(const bf16_t*)(a.ws + WS_H1B), (const bf16_t*)(a.ws + WS_PP), a.b_pg, a.out};
    pg8::gemm_phase(c.lds, (const char*)(a.ws + WS_H1B), D, S1, E);
}

constexpr int N_PHASES = 9 + 2 * NR;
__global__ void __launch_bounds__(512, 2) mega_fwd(Args a) {
    extern __shared__ __attribute__((aligned(16))) unsigned char lds_raw[];
    Ctx c; c.lds = (LAS unsigned char*)lds_raw; c.tid = threadIdx.x; c.lane = c.tid & 63; c.wave = __builtin_amdgcn_readfirstlane(c.tid >> 6);
    c.G = gridDim.x; { const int bx = blockIdx.x; c.vcu = (c.G % 8 == 0) ? (bx % 8) * (c.G / 8) + bx / 8 : bx; }
    volatile LAS unsigned* MISC = (volatile LAS unsigned*)(c.lds + MISC_OFF);
    if (c.tid < 64) MISC[c.tid] = 0u;
    __syncthreads();
    const bool one = (a.ph_hi - a.ph_lo) > 1;
    XcdBarrier bar; bar.bar = (unsigned*)(a.ws + WS_CTL) + CW_BAR; bar.x = 0; bar.st = MISC + 8;
    if (one) bar = xcd_barrier_post((unsigned*)(a.ws + WS_CTL) + CW_BAR, MISC + 8);
#ifndef PH_MASK
#define PH_MASK 0x7fffffff
#endif
#define PH(k) (((PH_MASK >> (k)) & 1) && a.ph_lo <= (k) && (k) < a.ph_hi)
#define SEAM(k) do { if (PH(k) && PH((k) + 1)) xcd_barrier(bar); } while (0)
    if (PH(0)) phase0(a, c);
    SEAM(0);
    if (PH(1)) phase1(a, c);
    SEAM(1);
    if (PH(2)) phase2(a, c);
    SEAM(2);
    if (PH(3)) phase3(a, c);
    SEAM(3);
    if (PH(4)) phase4(a, c);
    SEAM(4);
    if (PH(5)) phase5(a, c);
    SEAM(5);
    if (PH(6)) phase6(a, c);
    SEAM(6);
    for (int r = 0; r < NR; ++r) {
        const int k = 7 + 2 * r;
        if (PH(k)) { if (r > 0) phase9(a, c, r - 1); phase7(a, c, r); }
        SEAM(k);
        if (PH(k + 1)) phase8(a, c, r);
        SEAM(k + 1);
    }
    if (PH(7 + 2 * NR)) phase9(a, c, NR - 1);
    SEAM(7 + 2 * NR);
    if (PH(8 + 2 * NR)) phase10(a, c);
#undef PH
#undef SEAM
}

extern "C" void kernel_launch(void* const* d_in, const int* in_sizes, int n_in, void* d_out, int out_size, void* d_ws, size_t ws_size, hipStream_t stream) {
    static int grid = 0;
    if (grid == 0) {
        if (n_in != 27 || out_size != T * D || ws_size < WS_END) { fprintf(stderr, "kernel_launch: unexpected shapes (n_in %d out %d ws %zu)\n", n_in, out_size, ws_size); grid = -1; return; }
        int dev = 0, cus = 0, per_cu = 0;
        if (hipGetDevice(&dev) != hipSuccess || hipDeviceGetAttribute(&cus, hipDeviceAttributeMultiprocessorCount, dev) != hipSuccess) { grid = -1; return; }
        if (hipFuncSetAttribute((const void*)mega_fwd, hipFuncAttributeMaxDynamicSharedMemorySize, LDS_BYTES) != hipSuccess) { fprintf(stderr, "kernel_launch: hipFuncSetAttribute failed\n"); grid = -1; return; }
        if (hipOccupancyMaxActiveBlocksPerMultiprocessor(&per_cu, (const void*)mega_fwd, 512, LDS_BYTES) != hipSuccess || per_cu < 1) { fprintf(stderr, "kernel_launch: occupancy query says %d\n", per_cu); grid = -1; (void)hipGetLastError(); return; }
        if (cus > 256) cus = 256;
        if (T % (4 * cus * 8) != 0) { fprintf(stderr, "kernel_launch: unsupported CU count %d\n", cus); grid = -1; return; }
        grid = cus;
    }
    if (grid < 0) return;
    (void)hipMemsetAsync((char*)d_ws + WS_CTL, 0, CTL_ZERO_BYTES, stream);
    Args a{};
    a.x = (const float*)d_in[0]; a.p = (const float*)d_in[1]; a.positions = (const int*)d_in[2]; a.ln_emb_g = (const float*)d_in[3]; a.ln_emb_b = (const float*)d_in[4];
    a.w_in = (const float*)d_in[5]; a.w_o = (const float*)d_in[6]; a.lq1 = (const float*)d_in[7]; a.lk1 = (const float*)d_in[8]; a.lq2 = (const float*)d_in[9]; a.lk2 = (const float*)d_in[10];
    a.subln_g = (const float*)d_in[11]; a.ln1_g = (const float*)d_in[12]; a.ln1_b = (const float*)d_in[13]; a.w_router = (const float*)d_in[14]; a.router_bias = (const float*)d_in[15];
    a.w_eg = (const float*)d_in[16]; a.w_eu = (const float*)d_in[17]; a.w_ed = (const float*)d_in[18]; a.w_sg = (const float*)d_in[19]; a.w_su = (const float*)d_in[20]; a.w_sd = (const float*)d_in[21];
    a.ln2_g = (const float*)d_in[22]; a.ln2_b = (const float*)d_in[23]; a.w_pg = (const float*)d_in[24]; a.b_pg = (const float*)d_in[25]; a.w_pp = (const float*)d_in[26];
    a.out = (float*)d_out; a.ws = (unsigned char*)d_ws;
#if MK_N_LAUNCHES == 1
    a.ph_lo = 0; a.ph_hi = N_PHASES;
    void* args[] = {&a};
    hipError_t e = hipLaunchCooperativeKernel((const void*)mega_fwd, dim3(grid), dim3(512), args, LDS_BYTES, stream);
    if (e != hipSuccess) fprintf(stderr, "kernel_launch: cooperative launch failed: %s\n", hipGetErrorString(e));
#else
    for (int ph = 0; ph < N_PHASES; ++ph) { a.ph_lo = ph; a.ph_hi = ph + 1; hipLaunchKernelGGL(mega_fwd, dim3(grid), dim3(512), LDS_BYTES, stream, a); }
#endif
}
```

```cpp
#include <hip/hip_runtime.h>
#include <cstdio>
#include <cstdint>

#define LAS __attribute__((address_space(3)))
#define GAS __attribute__((address_space(1)))
typedef unsigned short bf16_t;
typedef short bf16x8 __attribute__((ext_vector_type(8)));
typedef float f32x4 __attribute__((ext_vector_type(4)));
typedef float f32x2 __attribute__((ext_vector_type(2)));
typedef float f32x16 __attribute__((ext_vector_type(16)));
typedef unsigned u32x4 __attribute__((ext_vector_type(4)));
typedef unsigned u32x2 __attribute__((ext_vector_type(2)));

#ifndef MK_N_LAUNCHES
#define MK_N_LAUNCHES 1
#endif

constexpr int NB = 4, S = 8192, T = NB * S, D = 1024;
constexpr int NPROJ = 3840;
constexpr int NE = 64, NEX = 65;
constexpr int NR = 2, RT = T / NR, TBR = RT / 128;
constexpr int RROUTED = RT * 8, RROWS = RROUTED + RT;
constexpr float QSCALE = 0.125f * 1.4426950408889634f;
constexpr float WSCALE = 0.04419417382415922f;
constexpr float ALPHA = 1.189207115002721f;
constexpr float LAMBDA_INIT = 0.2f;
constexpr float LN_EPS = 1e-5f, RMS_EPS = 1e-5f;
constexpr float NEGBIG = -1.0e30f;

constexpr size_t MiB = 1u << 20;
constexpr size_t WS_CTL = 0, CTL_ZERO_BYTES = 256 * 1024;
constexpr size_t WS_STATS0 = 1 * MiB;
constexpr size_t WS_WRP = 1 * MiB + 512 * 1024;
constexpr size_t WS_IW = 2 * MiB;
constexpr size_t WS_CNTWG = 3 * MiB;
constexpr size_t WS_TABLES = 3 * MiB + 512 * 1024;
constexpr size_t WS_EIDX = 4 * MiB;
constexpr size_t WS_GATE = 5 * MiB;
constexpr size_t WS_SLOTOF = 6 * MiB;
constexpr size_t WS_TOKBUF = 7 * MiB;
constexpr size_t WS_GWBUF = 9 * MiB;
constexpr size_t WS_YST = 12 * MiB;
constexpr size_t WS_IK = 12 * MiB;
constexpr size_t WS_WIN = 16 * MiB;
constexpr size_t WS_WO = 24 * MiB;
constexpr size_t WS_WPG = 26 * MiB;
constexpr size_t WS_WPP = 28 * MiB;
constexpr size_t WS_WGU = 29 * MiB;
constexpr size_t WS_WD = 94 * MiB;
constexpr size_t WS_CS = 127 * MiB;
constexpr size_t WS_H0B = 136 * MiB;
constexpr size_t WS_AO = 136 * MiB;
constexpr size_t WS_PB = 200 * MiB;
constexpr size_t WS_AQ = 216 * MiB, WS_AK = 248 * MiB, WS_AVT = 280 * MiB, WS_IQ = 312 * MiB, WS_BQ = 344 * MiB, WS_BK = 376 * MiB, WS_BVT = 408 * MiB;
constexpr size_t WS_MASK = 440 * MiB;
constexpr size_t WS_STASH = 457 * MiB;
constexpr size_t WS_Y1 = 216 * MiB;
constexpr size_t WS_H1B = 127 * MiB;
constexpr size_t WS_SLOTS = 191 * MiB;
constexpr size_t OUT_HID = 0, OUT_SLOTS_SH = 80 * MiB;
constexpr size_t WS_PP = 447 * MiB;
constexpr size_t WS_IXA = 127 * MiB, WS_IXB = 457 * MiB; constexpr int IX_NA = 146;
constexpr size_t WS_END = 512 * MiB;

constexpr int CW_BAR = 1024;

__device__ __forceinline__ unsigned f2bf(float f) { unsigned u = __builtin_bit_cast(unsigned, f); return (u + 0x7fffu + ((u >> 16) & 1u)) >> 16; }
typedef __bf16 bf16x2_t __attribute__((ext_vector_type(2)));
__device__ __forceinline__ unsigned pk2(float lo, float hi) { f32x2 v = {lo, hi}; bf16x2_t b = __builtin_convertvector(v, bf16x2_t); return __builtin_bit_cast(unsigned, b); }
__device__ __forceinline__ float bf2f(unsigned short b) { return __builtin_bit_cast(float, (unsigned)b << 16); }
template <int CTRL> __device__ __forceinline__ float dppf(float v) { return __builtin_bit_cast(float, __builtin_amdgcn_update_dpp(0, __builtin_bit_cast(int, v), CTRL, 0xf, 0xf, true)); }
__device__ __forceinline__ float rdlane(float v, int l) { return __builtin_bit_cast(float, __builtin_amdgcn_readlane(__builtin_bit_cast(int, v), l)); }
__device__ __forceinline__ float wave_sum(float v) {
    v += dppf<0xB1>(v); v += dppf<0x4E>(v); v += dppf<0x124>(v); v += dppf<0x128>(v);
    return (rdlane(v, 0) + rdlane(v, 16)) + (rdlane(v, 32) + rdlane(v, 48));
}
__device__ __forceinline__ float wave_max(float v) {
    v = fmaxf(v, dppf<0xB1>(v)); v = fmaxf(v, dppf<0x4E>(v)); v = fmaxf(v, dppf<0x124>(v)); v = fmaxf(v, dppf<0x128>(v));
    return fmaxf(fmaxf(rdlane(v, 0), rdlane(v, 16)), fmaxf(rdlane(v, 32), rdlane(v, 48)));
}
__device__ __forceinline__ float max8(float v) {
    v = fmaxf(v, dppf<0xB1>(v)); v = fmaxf(v, dppf<0x4E>(v)); return fmaxf(v, dppf<0x141>(v));
}
__device__ __forceinline__ int crow(int r, int hi) { return (r & 3) + 8 * (r >> 2) + 4 * hi; }
__device__ __forceinline__ int swz16(int s) { return (s & ~12) | ((s & 4) << 1) | ((s & 8) >> 1); }
__device__ __forceinline__ unsigned lds_add(LAS unsigned* p, unsigned v) { return __hip_atomic_fetch_add(p, v, __ATOMIC_RELAXED, __HIP_MEMORY_SCOPE_WORKGROUP); }
__device__ __forceinline__ void swap32(float v, float& own_or_partner0, float& own_or_partner1) { float a = v, b = v;
    asm volatile("s_nop 1\n\tv_permlane32_swap_b32 %0, %1" : "+v"(a), "+v"(b)); own_or_partner0 = a; own_or_partner1 = b; }
__device__ __forceinline__ void swap16(float v, float& own_or_partner0, float& own_or_partner1) { float a = v, b = v;
    asm volatile("s_nop 1\n\tv_permlane16_swap_b32 %0, %1" : "+v"(a), "+v"(b)); own_or_partner0 = a; own_or_partner1 = b; }
__device__ __forceinline__ float xsum32(float v) { float a, b; swap32(v, a, b); return a + b; }
__device__ __forceinline__ float xsum16(float v) { float a, b; swap16(v, a, b); return a + b; }
__device__ __forceinline__ float xmax32(float v) { float a, b; swap32(v, a, b); return fmaxf(a, b); }
#define LDS_WAIT() asm volatile("s_waitcnt lgkmcnt(0)" ::: "memory")
#define VM_WAIT() asm volatile("s_waitcnt vmcnt(0)" ::: "memory")

namespace pg8 {
constexpr int BM = 256, BK = 64, HALF = 128, HTB = HALF * BK * 2, STAGE_BYTES = 8 * HTB;
__host__ __device__ __forceinline__ int lds_byte(int r, int c) { const int st = (r >> 4) * 2 + (c >> 5), rr = r & 15, cc = c & 31, ob = rr * 64 + cc * 2; return st * 1024 + (ob ^ (((ob >> 9) & 1) << 5)); }
__host__ __device__ __forceinline__ void stage_rc(int b, int& R, int& C) { const int st = b / 1024, sb = b % 1024, swz = sb ^ (((sb >> 9) & 1) << 5); R = (st >> 1) * 16 + swz / 64; C = (st & 1) * 32 + (swz % 64) / 2; }

struct Unit { const char* bt; int arow; int i0, i1, i2; };

template <class Epi, class Sched, bool PERM = false>
__device__ __forceinline__ void gemm_phase(LAS unsigned char* lds, const char* Abase, const int K, const Sched& S, const Epi& E) {
    const int tid = threadIdx.x, wid = __builtin_amdgcn_readfirstlane(tid >> 6), lane = tid & 63, wr = wid >> 2, wc = wid & 3, fr = lane & 15, fq = lane >> 4;
    const int nt = K / BK;
    int Rr[2], Cc[2]; unsigned voffB[2];
#pragma unroll
    for (int i = 0; i < 2; ++i) { stage_rc(tid * 16 + i * 8192, Rr[i], Cc[i]); const int rho = Rr[i] & 31; const int Rb = PERM ? ((Rr[i] & ~31) + 8 * ((rho & 15) >> 2) + 4 * (rho >> 4) + (rho & 3)) : Rr[i];
        voffB[i] = (unsigned)(Rb * K + Cc[i]) * 2u; }
    const size_t kstep = (size_t)(BK * 2);
    const size_t hstepB = (size_t)HALF * K * 2;
    const unsigned ldsw = (unsigned)wid * 1024u;
    const int aoff = lds_byte(wr * 64 + fr, fq * 8), boff = lds_byte(wc * 32 + fr, fq * 8);
#define PG8_SA(b, h) (((b) * 2 + (h)) * HTB)
#define PG8_SB(b, h) ((4 + (b) * 2 + (h)) * HTB)
#define PG8_STAGE_B(bufoff, gbase) do { _Pragma("unroll") for (int _i = 0; _i < 2; ++_i) \
        __builtin_amdgcn_global_load_lds((const unsigned*)((const char*)(gbase) + voffB[_i]), (LAS unsigned*)(lds + (bufoff) + ldsw + _i * 8192), 16, 0, 0); } while (0)
#define PG8_STAGE_A(bufoff, kt, off) do { _Pragma("unroll") for (int _i = 0; _i < 2; ++_i) \
        __builtin_amdgcn_global_load_lds((const unsigned*)(Abase + (kt) + (off)[_i]), (LAS unsigned*)(lds + (bufoff) + ldsw + _i * 8192), 16, 0, 0); } while (0)
#define PG8_LDA(dst, b, h) do { _Pragma("unroll") for (int m = 0; m < 4; ++m) _Pragma("unroll") for (int k = 0; k < 2; ++k) dst[m][k] = *(const LAS bf16x8*)(lds + PG8_SA(b, h) + aoff + m * 2048 + k * 1024); } while (0)
#define PG8_LDB(dst, b, h) do { _Pragma("unroll") for (int n = 0; n < 2; ++n) _Pragma("unroll") for (int k = 0; k < 2; ++k) dst[n][k] = *(const LAS bf16x8*)(lds + PG8_SB(b, h) + boff + n * 2048 + k * 1024); } while (0)
#define PG8_MMA(ai, bj, At, Bt) do { __builtin_amdgcn_s_setprio(1); _Pragma("unroll") for (int m = 0; m < 4; ++m) _Pragma("unroll") for (int n = 0; n < 2; ++n) _Pragma("unroll") for (int k = 0; k < 2; ++k) \
        acc[ai][bj][m][n] = __builtin_amdgcn_mfma_f32_16x16x32_bf16(Bt[n][k], At[m][k], acc[ai][bj][m][n], 0, 0, 0); __builtin_amdgcn_s_setprio(0); } while (0)
#define PG8_WAIT_V(n) asm volatile("s_waitcnt vmcnt(" #n ")" ::: "memory")
#define PG8_WAIT_L(n) asm volatile("s_waitcnt lgkmcnt(" #n ")" ::: "memory")
#define PG8_BAR __builtin_amdgcn_s_barrier()
#define PG8_SCHED __builtin_amdgcn_sched_barrier(0)
    Unit cur, nxt; int ui = 0;
    if (!S.next(0, cur)) return;
    f32x4 acc[2][2][4][2];
#pragma unroll
    for (int a = 0; a < 2; ++a)
#pragma unroll
        for (int b = 0; b < 2; ++b)
#pragma unroll
            for (int m = 0; m < 4; ++m)
#pragma unroll
                for (int n = 0; n < 2; ++n) acc[a][b][m][n] = (f32x4){0.f, 0.f, 0.f, 0.f};
    bf16x8 At[4][2], B0[2][2], B1[2][2];
    unsigned oC0[2], oC1[2], oN0[2], oN1[2];
    S.aoffs(cur, Rr, Cc, K, oC0, oC1);
    const char* cB = cur.bt;
    PG8_STAGE_B(PG8_SB(0, 0), cB); PG8_STAGE_B(PG8_SB(0, 1), cB + hstepB); PG8_STAGE_A(PG8_SA(0, 0), 0, oC0); PG8_STAGE_A(PG8_SA(0, 1), 0, oC1);
    if (wr == 1) PG8_BAR;
    PG8_WAIT_V(2); PG8_BAR;
    PG8_STAGE_B(PG8_SB(1, 0), cB + kstep); PG8_STAGE_A(PG8_SA(1, 0), kstep, oC0); PG8_STAGE_B(PG8_SB(1, 1), cB + hstepB + kstep);
    PG8_WAIT_V(6); PG8_BAR;
    for (;;) {
        const bool has_next = S.next(ui + 1, nxt);
        const char* nB = has_next ? nxt.bt : cB;
        if (has_next) S.aoffs(nxt, Rr, Cc, K, oN0, oN1); else { oN0[0] = oC0[0]; oN0[1] = oC0[1]; oN1[0] = oC1[0]; oN1[1] = oC1[1]; }
#pragma unroll 1
        for (int t = 0; t < nt; t += 2) {
            const bool last = (t == nt - 2);
            const size_t kt1 = (size_t)(t + 1) * kstep;
            const size_t kt2 = last ? 0 : (size_t)(t + 2) * kstep, kt3 = kt2 + kstep;
            const char* b2 = last ? nB : cB + (size_t)(t + 2) * kstep; const char* b3 = b2 + kstep;
            unsigned p0[2], p1[2];
            p0[0] = last ? oN0[0] : oC0[0]; p0[1] = last ? oN0[1] : oC0[1]; p1[0] = last ? oN1[0] : oC1[0]; p1[1] = last ? oN1[1] : oC1[1];
            PG8_LDB(B0, 0, 0); PG8_LDB(B1, 0, 1); PG8_SCHED; PG8_LDA(At, 0, 0); PG8_STAGE_A(PG8_SA(1, 1), kt1, oC1);
            PG8_WAIT_V(8); PG8_WAIT_L(0); PG8_BAR; PG8_MMA(0, 0, At, B0); PG8_MMA(0, 1, At, B1); PG8_BAR; PG8_SCHED;
            PG8_LDA(At, 0, 1); PG8_STAGE_B(PG8_SB(0, 0), b2); PG8_STAGE_B(PG8_SB(0, 1), b2 + hstepB); PG8_STAGE_A(PG8_SA(0, 0), kt2, p0);
            PG8_WAIT_V(8); PG8_WAIT_L(0); PG8_BAR; PG8_MMA(1, 0, At, B0); PG8_MMA(1, 1, At, B1); PG8_BAR; PG8_SCHED;
            PG8_LDB(B0, 1, 0); PG8_LDB(B1, 1, 1); PG8_SCHED; PG8_LDA(At, 1, 0); PG8_STAGE_A(PG8_SA(0, 1), kt2, p1);
            PG8_WAIT_V(8); PG8_WAIT_L(0); PG8_BAR; PG8_MMA(0, 0, At, B0); PG8_MMA(0, 1, At, B1); PG8_BAR; PG8_SCHED;
            PG8_LDA(At, 1, 1); PG8_STAGE_B(PG8_SB(1, 0), b3); PG8_STAGE_B(PG8_SB(1, 1), b3 + hstepB); PG8_STAGE_A(PG8_SA(1, 0), kt3, p0);
            PG8_WAIT_V(8); PG8_WAIT_L(0); PG8_BAR; PG8_MMA(1, 0, At, B0); PG8_MMA(1, 1, At, B1); PG8_BAR; PG8_SCHED;
        }
        if (wr == 0) PG8_BAR;
        { int fr_ = fr, fq_ = fq; asm volatile("" : "+v"(fr_), "+v"(fq_)); E(acc, cur, wr, wc, fr_, fq_); }
        if (!has_next) break;
#pragma unroll
        for (int a = 0; a < 2; ++a)
#pragma unroll
            for (int b = 0; b < 2; ++b)
#pragma unroll
                for (int m = 0; m < 4; ++m)
#pragma unroll
                    for (int n = 0; n < 2; ++n) acc[a][b][m][n] = (f32x4){0.f, 0.f, 0.f, 0.f};
        cur = nxt; cB = nB; oC0[0] = oN0[0]; oC0[1] = oN0[1]; oC1[0] = oN1[0]; oC1[1] = oN1[1]; ++ui;
        if (wr == 1) PG8_BAR;
    }
    PG8_WAIT_V(0);
    PG8_BAR;
#undef PG8_SA
#undef PG8_SB
#undef PG8_STAGE_A
#undef PG8_STAGE_B
#undef PG8_LDA
#undef PG8_LDB
#undef PG8_MMA
#undef PG8_WAIT_V
#undef PG8_WAIT_L
#undef PG8_BAR
#undef PG8_SCHED
}

struct DenseOrder {
    const char* Bt; int K; int nM, nN, nwg, G, c;
    __device__ void init(const void* Bt_, int M, int N, int K_, int G_, int c_) { Bt = (const char*)Bt_; K = K_; nM = M / BM; nN = N / BM; nwg = nM * nN; G = G_; c = c_; }
    __device__ __forceinline__ bool next(int i, Unit& u) const {
        const long L = (long)i * G + c; if (L >= nwg) return false;
        int wgid = (int)L; { const int q = nwg / 8, r = nwg % 8, xcd = wgid % 8, off = wgid / 8; wgid = (xcd < r ? xcd * (q + 1) : r * (q + 1) + (xcd - r) * q) + off; }
        const int nig = 8 * nN, gid = wgid / nig, fm = gid * 8, gsz = (nM - fm) < 8 ? (nM - fm) : 8;
        const int pm = fm + ((wgid % nig) % gsz), pn = (wgid % nig) / gsz;
        u.bt = Bt + (size_t)pn * BM * K * 2; u.arow = pm * BM; u.i0 = pm; u.i1 = pn; u.i2 = 0; return true;
    }
    __device__ __forceinline__ void aoffs(const Unit& u, const int (&R)[2], const int (&C)[2], int K_, unsigned (&o0)[2], unsigned (&o1)[2]) const {
#pragma unroll
        for (int i = 0; i < 2; ++i) { o0[i] = (unsigned)((u.arow + R[i]) * K_ + C[i]) * 2u; o1[i] = (unsigned)((u.arow + HALF + R[i]) * K_ + C[i]) * 2u; }
    }
};
}

#define XB_TMO      128
#define XB_XCNT(j)  (256  + 64 * (j))
#define XB_XSUB(j)  (1280 + 64 * (j))
#define XB_XGEN(j)  (2304 + 64 * (j))
#define XB_TOP      3328
#define XB_TOPGEN   3392
#define XCD_BAR_WORDS 3456
#define XB_SPIN_CAP (1u << 20)
__device__ __forceinline__ unsigned xb_ld(unsigned* p)              { return __hip_atomic_load(p, __ATOMIC_RELAXED, __HIP_MEMORY_SCOPE_AGENT); }
__device__ __forceinline__ unsigned xb_add(unsigned* p, unsigned v) { return __hip_atomic_fetch_add(p, v, __ATOMIC_RELAXED, __HIP_MEMORY_SCOPE_AGENT); }
__device__ __forceinline__ unsigned xb_xcc_id() { return (unsigned)__builtin_amdgcn_s_getreg((3 << 11) | 20) & 0xFu; }
#define XB_SPIN(cond, bar) do { unsigned _sp = 0; while (cond) { __builtin_amdgcn_s_sleep(1); \
    if ((++_sp & 255u) == 0u) { if (xb_ld(&(bar)[XB_TMO])) break; if (_sp > XB_SPIN_CAP) { atomicAdd(&(bar)[XB_TMO], 1u); break; } } } } while (0)
struct XcdBarrier { unsigned* bar; unsigned x; volatile LAS unsigned* st; };
__device__ __forceinline__ XcdBarrier xcd_barrier_post(unsigned* bar, volatile LAS unsigned* st) {
    XcdBarrier b; b.bar = bar; b.x = xb_xcc_id(); b.st = st;
    if (threadIdx.x == 0) (void)xb_add(&bar[XB_XCNT(b.x)], 1u);
    return b;
}
__device__ __forceinline__ void xcd_barrier_complete(unsigned* bar, unsigned x, unsigned& nloc, unsigned& nx) {
    const unsigned G = gridDim.x * gridDim.y * gridDim.z;
    unsigned sum, cnt, mine, sp = 0u;
    for (;;) {
        sum = 0u; cnt = 0u; mine = 0u;
#pragma unroll
        for (unsigned j = 0; j < 16; ++j) { const unsigned c = xb_ld(&bar[XB_XCNT(j)]); sum += c; cnt += (c > 0u) ? 1u : 0u; mine = (j == x) ? c : mine; }
        if (sum == G) break;
        __builtin_amdgcn_s_sleep(1);
        if ((++sp & 255u) == 0u) { if (xb_ld(&bar[XB_TMO])) break; if (sp > XB_SPIN_CAP) { atomicAdd(&bar[XB_TMO], 1u); break; } }
    }
    nloc = mine > 0u ? mine : 1u; nx = cnt > 0u ? cnt : 1u;
}
__device__ __forceinline__ void xcd_barrier(const XcdBarrier& b) {
    asm volatile("s_waitcnt vmcnt(0)" ::: "memory");
    __syncthreads();
    if (threadIdx.x == 0) {
        unsigned* bar = b.bar;
        __builtin_amdgcn_s_waitcnt(0);
        unsigned nloc = b.st[0], nx = b.st[1];
        if (nloc == 0u) { xcd_barrier_complete(bar, b.x, nloc, nx); b.st[0] = nloc; b.st[1] = nx; }
        const unsigned old = xb_add(&bar[XB_XSUB(b.x)], 1u);
        const unsigned gen = old / nloc;
        if (old + 1u == (gen + 1u) * nloc) {
            __builtin_amdgcn_fence(__ATOMIC_RELEASE, "agent");
            asm volatile("s_waitcnt vmcnt(0)" ::: "memory");
            const unsigned og = xb_add(&bar[XB_TOP], 1u);
            const unsigned tg = og / nx;
            if (og + 1u == (tg + 1u) * nx) xb_add(&bar[XB_TOPGEN], 1u);
            else XB_SPIN(xb_ld(&bar[XB_TOPGEN]) == tg, bar);
            __builtin_amdgcn_fence(__ATOMIC_ACQUIRE, "agent");
            xb_add(&bar[XB_XGEN(b.x)], 1u);
            asm volatile("s_waitcnt vmcnt(0)" ::: "memory");
        } else {
            XB_SPIN(xb_ld(&bar[XB_XGEN(b.x)]) == gen, bar);
            __builtin_amdgcn_fence(__ATOMIC_ACQUIRE, "agent");
            asm volatile("s_waitcnt vmcnt(0)" ::: "memory");
        }
    }
    __syncthreads();
}

constexpr int RING_BYTES = 131072;
constexpr int MISC_OFF = 143360;
constexpr int LDS_BYTES = 147456;

struct Args {
    const float* x; const float* p; const int* positions; const float* ln_emb_g; const float* ln_emb_b; const float* w_in; const float* w_o;
    const float* lq1; const float* lk1; const float* lq2; const float* lk2; const float* subln_g; const float* ln1_g; const float* ln1_b;
    const float* w_router; const float* router_bias; const float* w_eg; const float* w_eu; const float* w_ed; const float* w_sg; const float* w_su; const float* w_sd;
    const float* ln2_g; const float* ln2_b; const float* w_pg; const float* b_pg; const float* w_pp;
    float* out; unsigned char* ws; int ph_lo, ph_hi;
};

struct Ctx {
    LAS unsigned char* lds; int tid, lane, wave, vcu, G;
};

template <class ColMap>
__device__ __forceinline__ void p0_transpose_item(const float* W, int K, int N, bf16_t* WT, int nprime_cnt, LAS float* scr, int item, int lane, const ColMap& cm) {
    const int nblk = nprime_cnt / 32, kb = item / nblk, nb = item % nblk, k0 = 64 * kb, n0 = 32 * nb;
    const int sc = cm(n0 + (lane & 31));
#pragma unroll 8
    for (int i = 0; i < 32; ++i) { const int kk = 2 * i + (lane >> 5); scr[kk * 33 + (lane & 31)] = sc >= 0 ? __builtin_nontemporal_load(W + (size_t)(k0 + kk) * N + sc) : 0.f; }
    LDS_WAIT(); asm volatile("" ::: "memory");
    const int c = lane & 7;
#pragma unroll
    for (int j = 0; j < 4; ++j) { const int n = (lane >> 3) + 8 * j; const LAS float* s = scr + (8 * c) * 33 + n;
        u32x4 o; o.x = pk2(s[0 * 33], s[1 * 33]); o.y = pk2(s[2 * 33], s[3 * 33]); o.z = pk2(s[4 * 33], s[5 * 33]); o.w = pk2(s[6 * 33], s[7 * 33]);
        *(GAS u32x4*)(WT + (size_t)(n0 + n) * K + k0 + 8 * c) = o; }
    LDS_WAIT(); asm volatile("" ::: "memory");
}
__device__ __forceinline__ int seg_d(int q) { return 16 * ((q >> 5) & 1) + 32 * ((q >> 4) & 1) + (q & 15); }
struct MapWin { __device__ int operator()(int n) const { const int seg = n >> 6, d = seg_d(n & 63);
        if (seg < 33) return 64 * seg + d; if (seg < 57) return 64 * seg + d + 8; if (seg == 57) return d < 8 ? 2112 + d : -1; return -1; } };
struct MapId { __device__ int operator()(int n) const { return n; } };

__device__ __forceinline__ void ln_row(const float* xrow, const float* g, const float* bb, int lane, f32x4 (&v)[4], float& mean, float& rstd) {
    const GAS f32x4* xr = (const GAS f32x4*)xrow + lane; float s = 0.f;
#pragma unroll
    for (int j = 0; j < 4; ++j) { v[j] = xr[64 * j]; s += (v[j].x + v[j].y) + (v[j].z + v[j].w); }
    mean = wave_sum(s) * (1.f / D); float s2 = 0.f;
#pragma unroll
    for (int j = 0; j < 4; ++j) { const f32x4 d = v[j] - mean; s2 += (d.x * d.x + d.y * d.y) + (d.z * d.z + d.w * d.w); }
    rstd = 1.f / sqrtf(wave_sum(s2) * (1.f / D) + LN_EPS);
#pragma unroll
    for (int j = 0; j < 4; ++j) { const f32x4 gg = *((const GAS f32x4*)g + lane + 64 * j), b4 = *((const GAS f32x4*)bb + lane + 64 * j); v[j] = (v[j] - mean) * rstd * gg + b4; }
}
template <bool NT = false>
__device__ __forceinline__ void ln_rows4(const float* const (&xrow)[4], const float* g, const float* bb, int lane, f32x4 (&v)[4][4], float (&mean)[4], float (&rstd)[4]) {
#pragma unroll
    for (int r = 0; r < 4; ++r) { const GAS f32x4* xr = (const GAS f32x4*)xrow[r] + lane;
#pragma unroll
        for (int j = 0; j < 4; ++j) v[r][j] = NT ? __builtin_nontemporal_load((const f32x4*)(xr + 64 * j)) : xr[64 * j]; }
#pragma unroll
    for (int r = 0; r < 4; ++r) { float s = 0.f;
#pragma unroll
        for (int j = 0; j < 4; ++j) s += (v[r][j].x + v[r][j].y) + (v[r][j].z + v[r][j].w);
        mean[r] = wave_sum(s) * (1.f / D); float s2 = 0.f;
#pragma unroll
        for (int j = 0; j < 4; ++j) { const f32x4 d = v[r][j] - mean[r]; s2 += (d.x * d.x + d.y * d.y) + (d.z * d.z + d.w * d.w); }
        rstd[r] = 1.f / sqrtf(wave_sum(s2) * (1.f / D) + LN_EPS); }
#pragma unroll
    for (int j = 0; j < 4; ++j) { const f32x4 gg = *((const GAS f32x4*)g + lane + 64 * j), b4 = *((const GAS f32x4*)bb + lane + 64 * j);
#pragma unroll
        for (int r = 0; r < 4; ++r) v[r][j] = (v[r][j] - mean[r]) * rstd[r] * gg + b4; }
}
__device__ __forceinline__ void store_row_bf16(bf16_t* orow, int lane, const f32x4 (&v)[4]) {
    GAS u32x2* o8 = (GAS u32x2*)orow + lane;
#pragma unroll
    for (int j = 0; j < 4; ++j) { u32x2 w; w.x = pk2(v[j].x, v[j].y); w.y = pk2(v[j].z, v[j].w); o8[64 * j] = w; }
}

__device__ __forceinline__ void phase0(const Args& a, const Ctx& c) {
    LAS float* scr = (LAS float*)(c.lds + c.wave * 16384);
    unsigned char* ws = a.ws;
    const int gw = c.vcu * 8 + c.wave, NGW = c.G * 8;
    constexpr int I_IN = 16 * (NPROJ / 32), I_O = 16 * 32, I_PG = 16 * 32, I_PP = 4 * 32, I_GU = 16 * 16, I_D = 4 * 32;
    constexpr int NITEMS = I_IN + I_O + I_PG + I_PP + NEX * (I_GU + I_D);
    for (int it = gw; it < NITEMS; it += NGW) {
        int r = it;
        if (r < I_IN) { p0_transpose_item(a.w_in, D, 3656, (bf16_t*)(ws + WS_WIN), NPROJ, scr, r, c.lane, MapWin()); continue; } r -= I_IN;
        if (r < I_O) { p0_transpose_item(a.w_o, D, D, (bf16_t*)(ws + WS_WO), D, scr, r, c.lane, MapId()); continue; } r -= I_O;
        if (r < I_PG) { p0_transpose_item(a.w_pg, D, D, (bf16_t*)(ws + WS_WPG), D, scr, r, c.lane, MapId()); continue; } r -= I_PG;
        if (r < I_PP) { p0_transpose_item(a.w_pp, 256, D, (bf16_t*)(ws + WS_WPP), D, scr, r, c.lane, MapId()); continue; } r -= I_PP;
        const int e = r / (I_GU + I_D); r -= e * (I_GU + I_D);
        if (r < I_GU) {
            const float* wg = e < NE ? a.w_eg + (size_t)e * D * 256 : a.w_sg; const float* wu = e < NE ? a.w_eu + (size_t)e * D * 256 : a.w_su;
            bf16_t* WT = (bf16_t*)(ws + WS_WGU) + (size_t)e * 512 * D;
            const int nblk = 512 / 32, kb = r / nblk, nb = r % nblk, k0 = 64 * kb, n0 = 32 * nb; const int lane = c.lane;
            const int q = lane & 31; const float* src = (q < 16) ? wg : wu; const int sc = 16 * nb + (q & 15);
#pragma unroll 8
            for (int i = 0; i < 32; ++i) { const int kk = 2 * i + (lane >> 5); scr[kk * 33 + q] = __builtin_nontemporal_load(src + (size_t)(k0 + kk) * 256 + sc); }
            LDS_WAIT(); asm volatile("" ::: "memory");
            const int cc = lane & 7;
#pragma unroll
            for (int j = 0; j < 4; ++j) { const int n = (lane >> 3) + 8 * j; const LAS float* s = scr + (8 * cc) * 33 + n;
                u32x4 o; o.x = pk2(s[0 * 33], s[1 * 33]); o.y = pk2(s[2 * 33], s[3 * 33]); o.z = pk2(s[4 * 33], s[5 * 33]); o.w = pk2(s[6 * 33], s[7 * 33]);
                *(GAS u32x4*)(WT + (size_t)(n0 + n) * D + k0 + 8 * cc) = o; }
            LDS_WAIT(); asm volatile("" ::: "memory");
            continue;
        }
        r -= I_GU;
        { const float* wd = e < NE ? a.w_ed + (size_t)e * 256 * D : a.w_sd; p0_transpose_item(wd, 256, D, (bf16_t*)(ws + WS_WD) + (size_t)e * D * 256, D, scr, r, c.lane, MapId()); }
    }
    for (int idx = c.vcu * 512 + c.tid; idx < 65536; idx += c.G * 512) {
        const int jj = idx & 3, r32 = (idx >> 2) & 31, hi = (idx >> 7) & 1, i = (idx >> 8) & 15, et = (idx >> 12) & 1, sl = idx >> 13;
        ((float*)(ws + WS_WRP))[idx] = a.w_router[(size_t)(128 * sl + 8 * i + 4 * hi + jj) * 64 + 32 * et + r32]; }
    for (int mb = gw; mb < T; mb += 4 * NGW) {
        f32x4 v4[4][4]; float mean4[4], rstd4[4];
        const float* const xr4[4] = {a.x + (size_t)mb * D, a.x + (size_t)(mb + NGW) * D, a.x + (size_t)(mb + 2 * NGW) * D, a.x + (size_t)(mb + 3 * NGW) * D};
        ln_rows4<true>(xr4, a.ln_emb_g, a.ln_emb_b, c.lane, v4, mean4, rstd4);
#pragma unroll
        for (int r = 0; r < 4; ++r) { const int m = mb + r * NGW;
            store_row_bf16((bf16_t*)(ws + WS_H0B) + (size_t)m * D, c.lane, v4[r]);
            if (c.lane == 0) { float* st = (float*)(ws + WS_STATS0) + 2 * m; st[0] = mean4[r]; st[1] = rstd4[r]; } }
      for (int r = 0; r < 4; ++r) { const int m = mb + r * NGW;
        { const f32x4 pv = *((const GAS f32x4*)(a.p + (size_t)m * 256) + c.lane); u32x2 w; w.x = pk2(pv.x, pv.y); w.y = pk2(pv.z, pv.w); *((GAS u32x2*)((bf16_t*)(ws + WS_PB) + (size_t)m * 256) + c.lane) = w; }
        if (c.lane < 32) { const double inv = pow(10000.0, -(double)c.lane / 32.0); const double ang = (double)a.positions[m] * inv; double sn, cs; sincos(ang, &sn, &cs);
            ((float*)(ws + WS_CS))[(size_t)m * 32 + c.lane] = (float)cs; ((float*)(ws + WS_CS) + (size_t)T * 32)[(size_t)m * 32 + c.lane] = (float)sn; }
      }
    }
}

struct EpiProj {
    unsigned char* ws; LAS unsigned char* tl;
    __device__ __forceinline__ void operator()(const f32x4 (&acc)[2][2][4][2], const pg8::Unit& u, int wr, int wc, int fr, int fq) const {
        const int pm = u.i0, pn = u.i1;
        const float* cosT = (const float*)(ws + WS_CS); const float* sinT = cosT + (size_t)T * 32;
        const int hh = wc & 1, d1 = 16 * hh + 4 * fq;
        int seg[2]; bool rope[2], isv[2];
#pragma unroll
        for (int bj = 0; bj < 2; ++bj) { seg[bj] = (pn * 256 + 128 * bj + 32 * wc) >> 6; isv[bj] = (seg[bj] >= 16 && seg[bj] < 24) || (seg[bj] >= 49 && seg[bj] < 57); rope[bj] = !isv[bj] && seg[bj] < 57; }
#pragma unroll
        for (int ai = 0; ai < 2; ++ai) {
            f32x4 cs[4], sn[4];
            if (rope[0] || rope[1]) {
#pragma unroll
                for (int m = 0; m < 4; ++m) { const int row = pm * 256 + 128 * ai + 64 * wr + 16 * m + fr; cs[m] = *(const GAS f32x4*)(cosT + (size_t)row * 32 + d1); sn[m] = *(const GAS f32x4*)(sinT + (size_t)row * 32 + d1); }
            }
#pragma unroll
            for (int bj = 0; bj < 2; ++bj) {
                const int sg = seg[bj];
                if (sg >= 58) continue;
                if (sg == 57) {
                    if (hh == 0 && fq < 2) {
#pragma unroll
                        for (int m = 0; m < 4; ++m) { const int row = pm * 256 + 128 * ai + 64 * wr + 16 * m + fr;
                            *(GAS f32x4*)((float*)(ws + WS_IW) + (size_t)row * 8 + d1) = acc[ai][bj][m][0] * WSCALE; }
                    }
                } else if (isv[bj]) {
                    bf16_t* base; int hb;
                    if (sg < 24) { base = (bf16_t*)(ws + WS_AVT); hb = (sg - 16) * 64; }
                    else { base = (bf16_t*)(ws + WS_BVT); hb = ((sg - 49) >> 1) * 128 + ((sg - 49) & 1) * 64; }
                    LAS unsigned char* tb = tl + (wr * 4 + wc) * 1024; const int lane_ = fq * 16 + fr, dvl = lane_ >> 1, half = lane_ & 1;
                    const int dtrue = 16 * hh + 32 * (dvl >> 4) + (dvl & 15); const int pos = swz16(fr);
#pragma unroll
                    for (int m = 0; m < 4; ++m) { const int row0 = pm * 256 + 128 * ai + 64 * wr + 16 * m; const int b = row0 >> 13, s16 = row0 & 8191;
                        const f32x4 x1 = acc[ai][bj][m][0], x2 = acc[ai][bj][m][1];
#pragma unroll
                        for (int i = 0; i < 4; ++i) { *(LAS bf16_t*)(tb + (4 * fq + i) * 32 + pos * 2) = (bf16_t)f2bf(x1[i]); *(LAS bf16_t*)(tb + (16 + 4 * fq + i) * 32 + pos * 2) = (bf16_t)f2bf(x2[i]); }
                        LDS_WAIT(); asm volatile("" ::: "memory");
                        const u32x4 v = *(const LAS u32x4*)(tb + dvl * 32 + half * 16);
                        *(GAS u32x4*)(base + ((size_t)(b * 512 + hb + dtrue)) * S + s16 + half * 8) = v;
                        LDS_WAIT(); asm volatile("" ::: "memory"); }
                } else {
                    bf16_t* base; int stride, col; float sc = 1.f;
                    if (sg < 8) { base = (bf16_t*)(ws + WS_AQ); stride = 512; col = sg * 64; sc = QSCALE; }
                    else if (sg < 16) { base = (bf16_t*)(ws + WS_AK); stride = 512; col = (sg - 8) * 64; }
                    else if (sg < 32) { base = (bf16_t*)(ws + WS_IQ); stride = 512; col = (sg - 24) * 64; }
                    else if (sg == 32) { base = (bf16_t*)(ws + WS_IK); stride = 64; col = 0; }
                    else if (sg < 41) { base = (bf16_t*)(ws + WS_BQ); stride = 512; col = (sg - 33) * 64; sc = QSCALE; }
                    else { base = (bf16_t*)(ws + WS_BK); stride = 512; col = (sg - 41) * 64; }
#pragma unroll
                    for (int m = 0; m < 4; ++m) { const int row = pm * 256 + 128 * ai + 64 * wr + 16 * m + fr;
                        const f32x4 x1 = acc[ai][bj][m][0], x2 = acc[ai][bj][m][1];
                        const f32x4 o1 = (x1 * cs[m] - x2 * sn[m]) * sc, o2 = (x2 * cs[m] + x1 * sn[m]) * sc;
                        bf16_t* p = base + (size_t)row * stride + col + 2 * d1;
                        u32x4 w; w.x = pk2(o1[0], o1[1]); w.y = pk2(o1[2], o1[3]); w.z = pk2(o2[0], o2[1]); w.w = pk2(o2[2], o2[3]);
                        *(GAS u32x4*)p = w; }
                }
            }
            asm volatile("" ::: "memory");
        }
    }
};
struct EpiBf16 {
    bf16_t* out;
    __device__ __forceinline__ void operator()(const f32x4 (&acc)[2][2][4][2], const pg8::Unit& u, int wr, int wc, int fr, int fq) const {
        const int pm = u.i0, pn = u.i1;
#pragma unroll
        for (int ai = 0; ai < 2; ++ai)
#pragma unroll
            for (int m = 0; m < 4; ++m) { const int row = pm * 256 + 128 * ai + 64 * wr + 16 * m + fr;
#pragma unroll
                for (int bj = 0; bj < 2; ++bj) { const f32x4 v0 = acc[ai][bj][m][0], v1 = acc[ai][bj][m][1]; u32x4 w; w.x = pk2(v0[0], v0[1]); w.y = pk2(v0[2], v0[3]); w.z = pk2(v1[0], v1[1]); w.w = pk2(v1[2], v1[3]);
                    *(GAS u32x4*)(out + (size_t)row * D + pn * 256 + 128 * bj + 32 * wc + 8 * fq) = w; } }
    }
};
__device__ __forceinline__ void phase1(const Args& a, const Ctx& c) {
    { pg8::DenseOrder S1; S1.init(a.ws + WS_WIN, T, NPROJ, D, c.G, (int)blockIdx.x); EpiProj E{a.ws, c.lds + RING_BYTES};
      pg8::gemm_phase(c.lds, (const char*)(a.ws + WS_H0B), D, S1, E); }
}

constexpr int IX_CAP = 256, IX_NBIN = 520;
constexpr int IXL_CS = 0, IXL_CI = 32768, IXL_MASK = 66560, IXL_Q = 99328, IX_QSTR = 1168, IXL_SM = 136704;
__device__ __forceinline__ void indexer_unit(const Args& a, const Ctx& c, int b, int ch, int half) {
    unsigned char* ws = a.ws; LAS unsigned char* lds = c.lds;
    int tid = c.tid; asm volatile("" : "+v"(tid));
    const int lane = tid & 63, wave = c.wave, r32 = lane & 31, hi = lane >> 5;
    const int ntile = 2 * (ch + 1);
    const int m0 = b * S + ch * 64 + half * 32;
    const bf16_t* IQ = (const bf16_t*)(ws + WS_IQ); const bf16_t* IK = (const bf16_t*)(ws + WS_IK) + (size_t)b * S * 64;
    LAS unsigned* hist = (LAS unsigned*)(lds + IXL_CS);
    LAS float* candS = (LAS float*)(lds + IXL_CS); LAS int* candI = (LAS int*)(lds + IXL_CI);
    LAS unsigned* maskL = (LAS unsigned*)(lds + IXL_MASK);
    LAS float* hiL = (LAS float*)(lds + IXL_SM); LAS float* loL = hiL + 32; LAS int* needL = (LAS int*)(loL + 32); LAS unsigned* ccntL = (LAS unsigned*)(needL + 32);
#pragma unroll
    for (int i = 0; i < 4; ++i) { const int idx = tid + 512 * i, row = idx >> 6, chn = idx & 63;
        *(LAS u32x4*)(lds + IXL_Q + row * IX_QSTR + chn * 16) = *(const GAS u32x4*)(IQ + (size_t)(m0 + row) * 512 + chn * 8); }
    for (int i = tid; i < 32 * 512; i += 512) hist[i] = 0u;
    if (tid < 32) ccntL[tid] = 0u;
    float wq[8];
    { const f32x4 w0 = *(const GAS f32x4*)((const float*)(ws + WS_IW) + (size_t)(m0 + r32) * 8), w1 = *(const GAS f32x4*)((const float*)(ws + WS_IW) + (size_t)(m0 + r32) * 8 + 4);
      wq[0] = 0.5f * w0[0]; wq[1] = 0.5f * w0[1]; wq[2] = 0.5f * w0[2]; wq[3] = 0.5f * w0[3]; wq[4] = 0.5f * w1[0]; wq[5] = 0.5f * w1[1]; wq[6] = 0.5f * w1[2]; wq[7] = 0.5f * w1[3]; }
    float bt = 0.f;
#pragma unroll
    for (int h = 0; h < 8; ++h) bt += fabsf(wq[h]);
    const float inv = bt > 0.f ? 3.2f / bt : 0.f;
    __syncthreads();
    {
        const int q = tid >> 4, d0 = (tid & 15) * 4; const float* wrow = (const float*)(ws + WS_IW) + (size_t)(m0 + q) * 8;
        float acc4[4] = {0.f, 0.f, 0.f, 0.f};
#pragma unroll
        for (int h = 0; h < 8; ++h) { const float wh = 0.5f * wrow[h]; const u32x2 v = *(const LAS u32x2*)(lds + IXL_Q + q * IX_QSTR + h * 128 + d0 * 2);
            acc4[0] += wh * __builtin_bit_cast(float, v.x << 16); acc4[1] += wh * __builtin_bit_cast(float, v.x & 0xffff0000u);
            acc4[2] += wh * __builtin_bit_cast(float, v.y << 16); acc4[3] += wh * __builtin_bit_cast(float, v.y & 0xffff0000u); }
        u32x2 o; o.x = pk2(acc4[0], acc4[1]); o.y = pk2(acc4[2], acc4[3]);
        *(LAS u32x2*)(lds + IXL_Q + q * IX_QSTR + 1024 + d0 * 2) = o;
    }
    __syncthreads();
    const LAS unsigned char* qb = lds + IXL_Q + r32 * IX_QSTR + hi * 16;
    unsigned* scr = (unsigned*)(ws + ((int)blockIdx.x < IX_NA ? WS_IXA + (size_t)blockIdx.x * 524288 : WS_IXB + (size_t)((int)blockIdx.x - IX_NA) * 524288)) + lane;
    const float inv16 = inv * 128.f;
#define IX_LDQ(QF, h) do { _Pragma("unroll") for (int ks = 0; ks < 4; ++ks) QF[ks] = *(const LAS bf16x8*)(qb + (h) * 128 + ks * 32); } while (0)
#define IX_HEAD(X, QF) do { X = __builtin_amdgcn_mfma_f32_32x32x16_bf16(kf[0], QF[0], zero16, 0, 0, 0); \
        _Pragma("unroll") for (int ks = 1; ks < 4; ++ks) X = __builtin_amdgcn_mfma_f32_32x32x16_bf16(kf[ks], QF[ks], X, 0, 0, 0); } while (0)
#define IX_ACC(X, h) do { _Pragma("unroll") for (int r = 0; r < 16; ++r) { float t_ = __builtin_fmaf(wq[h], __builtin_fabsf(X[r]), sc[r]); asm volatile("" : "+v"(t_)); sc[r] = t_; } } while (0)
    {
        bf16x8 qreg[8][4], qlin[4];
#pragma unroll
        for (int h = 0; h < 8; ++h) IX_LDQ(qreg[h], h);
        IX_LDQ(qlin, 8);
        bf16x8 kf[4], kn[4];
        if (wave < ntile) {
#pragma unroll
            for (int ks = 0; ks < 4; ++ks) kn[ks] = *(const GAS bf16x8*)(IK + (size_t)(wave * 32 + r32) * 64 + 16 * ks + 8 * hi);
        }
        for (int w = wave; w < ntile; w += 8) {
#pragma unroll
            for (int ks = 0; ks < 4; ++ks) kf[ks] = kn[ks];
            if (w + 8 < ntile) {
#pragma unroll
                for (int ks = 0; ks < 4; ++ks) kn[ks] = *(const GAS bf16x8*)(IK + (size_t)((w + 8) * 32 + r32) * 64 + 16 * ks + 8 * hi);
            }
            const f32x16 zero16 = {0.f, 0.f, 0.f, 0.f, 0.f, 0.f, 0.f, 0.f, 0.f, 0.f, 0.f, 0.f, 0.f, 0.f, 0.f, 0.f};
            f32x16 sc, xa, xb;
            IX_HEAD(sc, qlin);
            IX_HEAD(xa, qreg[0]);
#pragma unroll
            for (int h = 0; h < 8; h += 2) {
                __builtin_amdgcn_sched_barrier(0); IX_HEAD(xb, qreg[h + 1]); __builtin_amdgcn_sched_barrier(0);
                IX_ACC(xa, h);
                __builtin_amdgcn_sched_barrier(0); if (h + 2 < 8) { IX_HEAD(xa, qreg[h + 2]); } __builtin_amdgcn_sched_barrier(0);
                IX_ACC(xb, h + 1);
            }
            __builtin_amdgcn_sched_barrier(0); IX_LDQ(qlin, 8);
            unsigned code[16];
#pragma unroll
            for (int r = 0; r < 16; ++r) { int cd = (int)__builtin_fmaf(sc[r], inv16, 32768.5f); cd = cd < 0 ? 0 : cd; cd = cd > 65535 ? 65535 : cd; code[r] = (unsigned)cd;
                lds_add(&hist[r32 * 512 + (cd >> 7)], 1u); }
#pragma unroll
            for (int i = 0; i < 8; ++i) scr[(size_t)(w * 8 + i) * 64] = code[2 * i] | (code[2 * i + 1] << 16);
        }
    }
#undef IX_HEAD
#undef IX_LDQ
#undef IX_ACC
    __syncthreads();
    LAS unsigned* hiC = (LAS unsigned*)hiL; LAS unsigned* loC = (LAS unsigned*)loL;
    {
        const int q = wave * 4 + (lane >> 4), sub = lane & 15;
        u32x4 hb[8];
#pragma unroll
        for (int i = 0; i < 8; ++i) hb[i] = *(const LAS u32x4*)(hist + q * 512 + 32 * sub + 4 * i);
        int cl = 0;
#pragma unroll
        for (int i = 0; i < 8; ++i) cl += (int)(hb[i].x + hb[i].y + hb[i].z + hb[i].w);
        int incl = cl;
#pragma unroll
        for (int o = 1; o < 16; o <<= 1) { const int t = __shfl_up(incl, o, 16); if (sub >= o) incl += t; }
        const int total = __shfl(incl, 15, 16);
        const int suf = total - incl;
        if (total < 256) { if (sub == 0) { hiC[q] = 0u; loC[q] = 0u; needL[q] = 0; } }
        else if (suf < 256 && suf + cl >= 256) {
            int run = suf, bsel = 0, nd = 0; bool done = false;
#pragma unroll
            for (int i = 7; i >= 0; --i)
#pragma unroll
                for (int e = 3; e >= 0; --e) { const int cn = (int)hb[i][e]; if (!done) { if (run + cn >= 256) { bsel = 32 * sub + 4 * i + e; nd = 256 - run; done = true; } else run += cn; } }
            hiC[q] = (unsigned)(bsel + 1) << 7; loC[q] = (unsigned)bsel << 7; needL[q] = nd;
        }
    }
    __syncthreads();
    {
        const unsigned hiT = hiC[r32], loT = loC[r32];
        LAS unsigned* candC = (LAS unsigned*)candS;
        unsigned pk[8], pn_[8];
        if (wave < ntile) {
#pragma unroll
            for (int i = 0; i < 8; ++i) pn_[i] = scr[(size_t)(wave * 8 + i) * 64];
        }
        for (int w = wave; w < ntile; w += 8) {
#pragma unroll
            for (int i = 0; i < 8; ++i) pk[i] = pn_[i];
            if (w + 8 < ntile) {
#pragma unroll
                for (int i = 0; i < 8; ++i) pn_[i] = scr[(size_t)((w + 8) * 8 + i) * 64];
            }
            unsigned bits = 0u;
#pragma unroll
            for (int r = 0; r < 16; ++r) { const unsigned cd = (r & 1) ? (pk[r >> 1] >> 16) : (pk[r >> 1] & 0xffffu); const int kb = crow(r, hi);
                const bool sel = cd >= hiT;
                bits |= sel ? (1u << kb) : 0u;
                if (cd >= loT && !sel) { const unsigned pos = lds_add(&ccntL[r32], 1u); if (pos < (unsigned)IX_CAP) { candC[r32 * IX_CAP + pos] = cd; candI[r32 * IX_CAP + pos] = w * 32 + kb; } } }
            bits |= (unsigned)__shfl_xor((int)bits, 32);
            if (lane < 32) maskL[w * 32 + r32] = bits;
        }
    }
    __syncthreads();
    {   const LAS unsigned* candC2 = (const LAS unsigned*)candS;
        for (int qi = 0; qi < 4; ++qi) { const int q = wave * 4 + qi;
            const int nc = min((int)ccntL[q], IX_CAP), nd = needL[q];
            if (nc == 0 || nd <= 0) continue;
            unsigned key[4]; int kidx[4];
#pragma unroll
            for (int cch = 0; cch < 4; ++cch) { const int p = cch * 64 + lane; const bool valid = p < nc;
                const unsigned cd = valid ? candC2[q * IX_CAP + p] : 0u; kidx[cch] = valid ? candI[q * IX_CAP + p] : 0;
                key[cch] = valid ? (((cd << 13) | (unsigned)(8191 - kidx[cch])) + 1u) : 0u; }
            unsigned thr = 1u;
            if (nc > nd) { thr = 0u;
                for (int bit = 29; bit >= 0; --bit) { const unsigned cand = thr | (1u << bit); int cnt = 0;
#pragma unroll
                    for (int cch = 0; cch < 4; ++cch) cnt += __builtin_popcountll(__ballot(key[cch] >= cand));
                    if (cnt >= nd) thr = cand; } }
#pragma unroll
            for (int cch = 0; cch < 4; ++cch) if (key[cch] >= thr && key[cch] != 0u) __hip_atomic_fetch_or(&maskL[(kidx[cch] >> 5) * 32 + q], 1u << (kidx[cch] & 31), __ATOMIC_RELAXED, __HIP_MEMORY_SCOPE_WORKGROUP);
        }
    }
    __syncthreads();
    unsigned* gm = (unsigned*)(ws + WS_MASK) + ((size_t)b * 16512 + (size_t)ch * (ch + 1)) * 64 + half * 32;
    for (int idx = tid; idx < ntile * 32; idx += 512) gm[(size_t)(idx >> 5) * 64 + (idx & 31)] = maskL[idx];
    __syncthreads();
}
__device__ __forceinline__ void phase2(const Args& a, const Ctx& c) {
    for (int job = c.vcu; job < 512; job += c.G) { const int b = job >> 7, cp = (job >> 1) & 63, half = job & 1;
        indexer_unit(a, c, b, cp, half); indexer_unit(a, c, b, 127 - cp, half); }
}

constexpr int AT_KB = 9216, AT_VOFF = 2 * AT_KB, AT_TR = 73728, AT_TRW = 8704, AT_TSTR = 272;
template <int DV, bool MASKED>
__device__ __forceinline__ void attn_run(const Ctx& c, const bf16_t* Qrow0, const bf16_t* Krow0, const bf16_t* VT, const unsigned* gmask_b, int q0, f32x16 (&o)[DV / 32], float& lsum) {
    LAS unsigned char* lds = c.lds;
    int tid = c.tid; asm volatile("" : "+v"(tid));
    const int lane = tid & 63, wave = c.wave, r32 = lane & 31, hi = lane >> 5;
    constexpr int NV = DV / 64, VB = DV * 144, NPV = DV / 8;
    const int qw0 = q0 + 32 * wave, cw = qw0 >> 6, NTw = cw + 1, NT = (q0 >> 6) + 4;
    bf16x8 qf[4];
#pragma unroll
    for (int ks = 0; ks < 4; ++ks) qf[ks] = *(const GAS bf16x8*)(Qrow0 + (size_t)(32 * wave + r32) * 512 + 16 * ks + 8 * hi);
#pragma unroll
    for (int i = 0; i < DV / 32; ++i) o[i] = (f32x16){0.f, 0.f, 0.f, 0.f, 0.f, 0.f, 0.f, 0.f, 0.f, 0.f, 0.f, 0.f, 0.f, 0.f, 0.f, 0.f};
    float mref = 0.f, lrun = 0.f;
    f32x16 negm = {0.f, 0.f, 0.f, 0.f, 0.f, 0.f, 0.f, 0.f, 0.f, 0.f, 0.f, 0.f, 0.f, 0.f, 0.f, 0.f};
    u32x4 kreg, vreg[NV];
    const int krow = tid >> 3, kch = tid & 7;
    const LAS unsigned char* kfb = lds + r32 * 144 + hi * 16;
    const LAS unsigned char* vfb = lds + AT_VOFF + r32 * 144 + hi * 16;
#define AT_LOADK(t) do { kreg = *(const GAS u32x4*)(Krow0 + (size_t)((t) * 64 + krow) * 512 + kch * 8); } while (0)
#define AT_LOADV(t) do { _Pragma("unroll") for (int _i = 0; _i < NV; ++_i) vreg[_i] = *(const GAS u32x4*)(VT + (size_t)(krow + 64 * _i) * S + (t) * 64 + kch * 8); } while (0)
#define AT_STOREK(bf) do { *(LAS u32x4*)(lds + (bf) * AT_KB + krow * 144 + kch * 16) = kreg; } while (0)
#define AT_STOREV(vi) do { _Pragma("unroll") for (int _i = 0; _i < NV; ++_i) *(LAS u32x4*)(lds + AT_VOFF + (vi) * VB + (krow + 64 * _i) * 144 + kch * 16) = vreg[_i]; } while (0)
#define AT_KF(bf, g) (*(const LAS bf16x8*)(kfb + (bf) * AT_KB + ((g) & 1) * (32 * 144) + ((g) >> 1) * 32))
#define AT_VF(vi, g) (*(const LAS bf16x8*)(vfb + (vi) * VB + ((g) >> 2) * (32 * 144) + ((g) & 3) * 32))
#define AT_SBAR() __builtin_amdgcn_sched_barrier(0)
#define AT_MAX(X0, X1, mx) do { mx = fmaxf(fmaxf(X0[0], X1[0]), fmaxf(X0[1], X1[1])); \
        _Pragma("unroll") for (int r = 2; r < 16; r += 2) mx = fmaxf(fmaxf(mx, X0[r]), fmaxf(X1[r], fmaxf(X0[r + 1], X1[r + 1]))); \
        mx = xmax32(mx); } while (0)
#define AT_EXP4(X0, X1, g) do { _Pragma("unroll") for (int r = 4 * (g); r < 4 * (g) + 4; ++r) { float p0 = __builtin_amdgcn_exp2f(X0[r]), p1 = __builtin_amdgcn_exp2f(X1[r]); \
            if (MASKED) { const int kbit = (r & 3) + 8 * (r >> 2); int m0_, m1_; asm("v_bfe_i32 %0, %1, %2, 1" : "=v"(m0_) : "v"(w0), "n"(kbit)); asm("v_bfe_i32 %0, %1, %2, 1" : "=v"(m1_) : "v"(w1), "n"(kbit)); \
                p0 = __builtin_bit_cast(float, __builtin_bit_cast(int, p0) & m0_); p1 = __builtin_bit_cast(float, __builtin_bit_cast(int, p1) & m1_); } \
            X0[r] = p0; X1[r] = p1; } } while (0)
    AT_LOADK(0); AT_STOREK(0); AT_LOADV(0); AT_STOREV(0); AT_LOADK(1); AT_STOREK(1);
    __syncthreads();
    const unsigned* mrow = MASKED ? gmask_b + ((size_t)cw * (cw + 1)) * 64 + (qw0 & 63) + r32 : nullptr;
    f32x16 pa0, pa1, pb0, pb1;
    bf16x8 pk[2][2];
    int w0 = -1, w1 = -1;
    {
#pragma unroll
        for (int g = 0; g < 8; ++g) { const bf16x8 kf = AT_KF(0, g);
            if (g & 1) pa1 = __builtin_amdgcn_mfma_f32_32x32x16_bf16(kf, qf[g >> 1], g < 2 ? negm : pa1, 0, 0, 0); else pa0 = __builtin_amdgcn_mfma_f32_32x32x16_bf16(kf, qf[g >> 1], g < 2 ? negm : pa0, 0, 0, 0); }
        float mx; AT_MAX(pa0, pa1, mx); mref = mx;
#pragma unroll
        for (int r = 0; r < 16; ++r) { negm[r] = -mref; pa0[r] -= mref; pa1[r] -= mref; }
        if (MASKED) { w0 = (int)(mrow[0] >> (4 * hi)); w1 = (int)(mrow[64] >> (4 * hi)); }
#pragma unroll
        for (int g = 0; g < 4; ++g) AT_EXP4(pa0, pa1, g);
    }
    __syncthreads();
#define AT_STEP(t, Y0, Y1, X0, X1) do { \
        const int kb_ = (t) & 1, vb_ = ((t) - 1) & 1; \
        if ((t) + 1 < NT) AT_LOADK((t) + 1); \
        if ((t) < NT) AT_LOADV(t); \
        if ((t) <= NTw) {                               \
            float sacc = 0.f, fres = 1.f; \
            if (MASKED) { w0 = (int)(mrow[(size_t)(2 * (t)) * 64] >> (4 * hi)); w1 = (int)(mrow[(size_t)(2 * (t) + 1) * 64] >> (4 * hi)); } \
              \
            bf16x8 kfr[8]; kfr[0] = AT_KF(kb_, 0); kfr[1] = AT_KF(kb_, 1); \
            AT_SBAR(); \
            _Pragma("unroll") for (int g = 0; g < 8; ++g) { if (g + 2 < 8) kfr[g + 2] = AT_KF(kb_, g + 2); const bf16x8 kf = kfr[g]; \
                if (g & 1) X1 = __builtin_amdgcn_mfma_f32_32x32x16_bf16(kf, qf[g >> 1], g < 2 ? negm : X1, 0, 0, 0); else X0 = __builtin_amdgcn_mfma_f32_32x32x16_bf16(kf, qf[g >> 1], g < 2 ? negm : X0, 0, 0, 0); \
                  \
                { float t0_, t1_; asm("v_add_f32 %0, %1, %2" : "=v"(t0_) : "v"(Y0[2 * g]), "v"(Y0[2 * g + 1])); asm("v_add_f32 %0, %1, %2" : "=v"(t1_) : "v"(Y1[2 * g]), "v"(Y1[2 * g + 1])); \
                  asm("v_add_f32 %0, %1, %2" : "=v"(t0_) : "v"(t0_), "v"(t1_)); asm("v_add_f32 %0, %1, %2" : "+v"(sacc) : "v"(sacc), "v"(t0_)); }     \
                { const int s_ = g >> 2, j_ = g & 3; unsigned a_ = pk2(Y0[2 * g], Y0[2 * g + 1]), b_ = pk2(Y1[2 * g], Y1[2 * g + 1]); \
                  u32x4 t0_ = __builtin_bit_cast(u32x4, pk[0][s_]), t1_ = __builtin_bit_cast(u32x4, pk[1][s_]); t0_[j_] = a_; t1_[j_] = b_; pk[0][s_] = __builtin_bit_cast(bf16x8, t0_); pk[1][s_] = __builtin_bit_cast(bf16x8, t1_); } \
                AT_SBAR(); } \
            lrun += sacc; \
              \
            float dl; { const float tot_ = xsum32(sacc);     \
              dl = (tot_ > 65536.f && tot_ < 1.0e30f) ? (float)((int)(__builtin_bit_cast(unsigned, tot_) >> 23) - 127) : 0.f; }     \
            if (__any(dl != 0.f)) { mref += dl; fres = __builtin_amdgcn_exp2f(-dl); lrun *= fres; \
                _Pragma("unroll") for (int r = 0; r < 16; ++r) { X0[r] -= dl; X1[r] -= dl; negm[r] = -mref; } } \
              \
            bf16x8 vfr[NPV]; vfr[0] = AT_VF(vb_, 0); vfr[1] = AT_VF(vb_, 1); \
            AT_SBAR(); \
            _Pragma("unroll") for (int g = 0; g < NPV; ++g) { if (g + 2 < NPV) vfr[g + 2] = AT_VF(vb_, g + 2); \
                o[g >> 2] = __builtin_amdgcn_mfma_f32_32x32x16_bf16(vfr[g], pk[(g >> 1) & 1][g & 1], o[g >> 2], 0, 0, 0); \
                if (NPV == 16) { if (!(g & 3)) AT_EXP4(X0, X1, g >> 2); } else { if (!(g & 1)) AT_EXP4(X0, X1, g >> 1); } \
                AT_SBAR(); } \
            if (__any(fres != 1.f)) { _Pragma("unroll") for (int i = 0; i < DV / 32; ++i) o[i] = o[i] * fres; }     \
        } \
        if ((t) + 1 < NT) AT_STOREK(((t) + 1) & 1); \
        if ((t) < NT) AT_STOREV((t) & 1); \
        __syncthreads(); \
    } while (0)
#pragma unroll 1
    for (int t = 1; t <= NT; t += 2) { AT_STEP(t, pa0, pa1, pb0, pb1); if (t + 1 <= NT) AT_STEP(t + 1, pb0, pb1, pa0, pa1); }
#undef AT_STEP
#undef AT_EXP4
#undef AT_MAX
#undef AT_SBAR
#undef AT_KF
#undef AT_VF
#undef AT_LOADK
#undef AT_LOADV
#undef AT_STOREK
#undef AT_STOREV
    lsum = lrun + __shfl_xor(lrun, 32);
}
template <int DV>
__device__ __forceinline__ void attn_store(const Ctx& c, const f32x16 (&v)[DV / 32], bf16_t* dst) {
    LAS unsigned char* tb = c.lds + AT_TR + c.wave * AT_TRW;
    int lane = c.lane; asm volatile("" : "+v"(lane));
    const int r32 = lane & 31, hi = lane >> 5;
#pragma unroll
    for (int i = 0; i < DV / 32; ++i)
#pragma unroll
        for (int g = 0; g < 4; ++g) { u32x2 w; w.x = pk2(v[i][4 * g], v[i][4 * g + 1]); w.y = pk2(v[i][4 * g + 2], v[i][4 * g + 3]);
            *(LAS u32x2*)(tb + r32 * AT_TSTR + (32 * i + 8 * g + 4 * hi) * 2) = w; }
    LDS_WAIT(); asm volatile("" ::: "memory");
    constexpr int CPR = DV / 8;
#pragma unroll
    for (int k = 0; k < DV / 16; ++k) { const int idx = lane + 64 * k, row = idx / CPR, ch = idx % CPR;
        *(GAS u32x4*)(dst + (size_t)row * D + ch * 8) = *(const LAS u32x4*)(tb + row * AT_TSTR + ch * 16); }
    LDS_WAIT(); asm volatile("" ::: "memory");
}
__device__ __forceinline__ void attn_unit_A(const Args& a, const Ctx& c, int b, int head, int qblk) {
    unsigned char* ws = a.ws; const int q0 = qblk * 256;
    f32x16 o[2]; float l;
    attn_run<64, true>(c, (const bf16_t*)(ws + WS_AQ) + (size_t)(b * S + q0) * 512 + head * 64, (const bf16_t*)(ws + WS_AK) + (size_t)b * S * 512 + head * 64,
                       (const bf16_t*)(ws + WS_AVT) + (size_t)(b * 8 + head) * 64 * S, (const unsigned*)(ws + WS_MASK) + (size_t)b * 16512 * 64, q0, o, l);
    const float il = l > 0.f ? 1.f / l : 0.f;
    o[0] = o[0] * il; o[1] = o[1] * il;
    attn_store<64>(c, o, (bf16_t*)(ws + WS_AO) + (size_t)(b * S + q0 + 32 * c.wave) * D + head * 64);
}
__device__ __forceinline__ void attn_unit_B(const Args& a, const Ctx& c, int b, int head, int qblk, float lam) {
    unsigned char* ws = a.ws; const int q0 = qblk * 256; int lane = c.lane; asm volatile("" : "+v"(lane)); const int hi = lane >> 5;
    float* st = (float*)(ws + WS_STASH) + ((size_t)(blockIdx.x * 8 + c.wave) * 64 + lane) * 64;
    const bf16_t* VT = (const bf16_t*)(ws + WS_BVT) + (size_t)(b * 4 + head) * 128 * S;
    {   f32x16 o1[4]; float l1;
        attn_run<128, false>(c, (const bf16_t*)(ws + WS_BQ) + (size_t)(b * S + q0) * 512 + (2 * head) * 64, (const bf16_t*)(ws + WS_BK) + (size_t)b * S * 512 + (2 * head) * 64, VT, nullptr, q0, o1, l1);
        const float il = l1 > 0.f ? 1.f / l1 : 0.f;
#pragma unroll
        for (int i = 0; i < 4; ++i)
#pragma unroll
            for (int g = 0; g < 4; ++g) *(GAS f32x4*)(st + i * 16 + 4 * g) = (f32x4){o1[i][4 * g], o1[i][4 * g + 1], o1[i][4 * g + 2], o1[i][4 * g + 3]} * il;
    }
    f32x16 o2[4]; float l2;
    attn_run<128, false>(c, (const bf16_t*)(ws + WS_BQ) + (size_t)(b * S + q0) * 512 + (2 * head + 1) * 64, (const bf16_t*)(ws + WS_BK) + (size_t)b * S * 512 + (2 * head + 1) * 64, VT, nullptr, q0, o2, l2);
    const float il2 = l2 > 0.f ? lam / l2 : 0.f; float ss = 0.f;
#pragma unroll
    for (int i = 0; i < 4; ++i)
#pragma unroll
        for (int g = 0; g < 4; ++g) { const f32x4 sv = *(const GAS f32x4*)(st + i * 16 + 4 * g);
#pragma unroll
            for (int j = 0; j < 4; ++j) { const float d = sv[j] - o2[i][4 * g + j] * il2; o2[i][4 * g + j] = d; ss += d * d; } }
    ss += __shfl_xor(ss, 32);
    const float rr = (1.f / sqrtf(ss * (1.f / 128.f) + RMS_EPS)) * (1.f - LAMBDA_INIT);
#pragma unroll
    for (int i = 0; i < 4; ++i)
#pragma unroll
        for (int g = 0; g < 4; ++g) { const f32x4 gg = *(const GAS f32x4*)(a.subln_g + 32 * i + 8 * g + 4 * hi);
#pragma unroll
            for (int j = 0; j < 4; ++j) o2[i][4 * g + j] = o2[i][4 * g + j] * rr * gg[j]; }
    attn_store<128>(c, o2, (bf16_t*)(ws + WS_AO) + (size_t)(b * S + q0 + 32 * c.wave) * D + 512 + head * 128);
}
__device__ __forceinline__ void phase3(const Args& a, const Ctx& c) {
    float lam;
    { const float p1 = a.lq1[c.lane] * a.lk1[c.lane], p2 = a.lq2[c.lane] * a.lk2[c.lane]; lam = expf(wave_sum(p1)) - expf(wave_sum(p2)) + LAMBDA_INIT; }
    for (int job = c.vcu; job < 768; job += c.G) {
        if (job < 256) { const int b = job >> 6, head = (job >> 4) & 3, j = job & 15; attn_unit_B(a, c, b, head, j, lam); attn_unit_B(a, c, b, head, 31 - j, lam); }
        else { const int p = job - 256, b = p >> 7, head = (p >> 4) & 7, j = p & 15; attn_unit_A(a, c, b, head, j); attn_unit_A(a, c, b, head, 31 - j); }
    }
}

struct EpiY1 {
    const float* x; const float* st; const float* g; const float* bb; float* y1; f32x2* yst;
    __device__ __forceinline__ void operator()(const f32x4 (&acc)[2][2][4][2], const pg8::Unit& u, int wr, int wc, int fr, int fq) const {
        const int pm = u.i0, pn = u.i1; const int col0 = pn * 256 + 32 * wc + 4 * fq;
        f32x4 gv[2][2], bv[2][2];
#pragma unroll
        for (int bj = 0; bj < 2; ++bj)
#pragma unroll
            for (int n = 0; n < 2; ++n) { gv[bj][n] = *(const GAS f32x4*)(g + col0 + 128 * bj + 16 * n); bv[bj][n] = *(const GAS f32x4*)(bb + col0 + 128 * bj + 16 * n); }
#pragma unroll
        for (int ai = 0; ai < 2; ++ai)
#pragma unroll
            for (int m = 0; m < 4; ++m) { const int row = pm * 256 + 128 * ai + 64 * wr + 16 * m + fr;
                const f32x2 ms = *(const GAS f32x2*)(st + 2 * row);
                f32x4 xv[2][2];
#pragma unroll
                for (int bj = 0; bj < 2; ++bj)
#pragma unroll
                    for (int n = 0; n < 2; ++n) xv[bj][n] = *(const GAS f32x4*)(x + (size_t)row * D + col0 + 128 * bj + 16 * n);
                f32x4 s4 = {0.f, 0.f, 0.f, 0.f}, q4 = {0.f, 0.f, 0.f, 0.f};
#pragma unroll
                for (int bj = 0; bj < 2; ++bj)
#pragma unroll
                    for (int n = 0; n < 2; ++n) { const f32x4 yv = ((xv[bj][n] - ms.x) * ms.y * gv[bj][n] + bv[bj][n]) * ALPHA + acc[ai][bj][m][n]; s4 += yv; q4 += yv * yv;
                        *(GAS f32x4*)(y1 + (size_t)row * D + col0 + 128 * bj + 16 * n) = yv; }
                float sv = (s4.x + s4.y) + (s4.z + s4.w), qv = (q4.x + q4.y) + (q4.z + q4.w);
                sv = xsum32(xsum16(sv)); qv = xsum32(xsum16(qv));
                if (fq == 0) yst[(size_t)row * 16 + pn * 4 + wc] = (f32x2){sv, qv}; }
    }
};
__device__ __forceinline__ void phase4(const Args& a, const Ctx& c) {
    pg8::DenseOrder S1; S1.init(a.ws + WS_WO, T, D, D, c.G, (int)blockIdx.x);
    EpiY1 E{a.x, (const float*)(a.ws + WS_STATS0), a.ln_emb_g, a.ln_emb_b, (float*)(a.ws + WS_Y1), (f32x2*)(a.ws + WS_YST)};
    pg8::gemm_phase(c.lds, (const char*)(a.ws + WS_AO), D, S1, E);
    { pg8::DenseOrder S2; S2.init(a.ws + WS_WPP, T, D, 256, c.G, (int)blockIdx.x); EpiBf16 E2{(bf16_t*)(a.ws + WS_PP)};
      pg8::gemm_phase<EpiBf16, pg8::DenseOrder, true>(c.lds, (const char*)(a.ws + WS_PB), 256, S2, E2); }
}

constexpr int P5_HSTR = 132;
constexpr int P5_W = 128 * P5_HSTR * 4, P5_STATS = P5_W + 32768, P5_CNT = P5_STATS + 1024;
__device__ __forceinline__ void phase5(const Args& a, const Ctx& c) {
    unsigned char* ws = a.ws; LAS unsigned char* lds = c.lds; const int tid = c.tid, lane = c.lane, wave = c.wave;
    LAS float* hsL = (LAS float*)lds; LAS float* wL = (LAS float*)(lds + P5_W); LAS float* statsL = (LAS float*)(lds + P5_STATS); LAS float* logitL = (LAS float*)lds; LAS unsigned* cntL = (LAS unsigned*)(lds + P5_CNT);
    const float* y1 = (const float*)(ws + WS_Y1);
    for (int tb = c.vcu; tb < 256; tb += c.G) {
        const int m0 = tb * 128;
        if (lane < 16) {
            const int row = wave * 16 + lane; const f32x4* pp = (const f32x4*)((const f32x2*)(ws + WS_YST) + (size_t)(m0 + row) * 16);
            float sm = 0.f, sq = 0.f;
#pragma unroll
            for (int i = 0; i < 8; ++i) { const f32x4 v = pp[i]; sm += v.x; sq += v.y; sm += v.z; sq += v.w; }
            const float mean = sm * (1.f / D), var = fmaxf(sq * (1.f / D) - mean * mean, 0.f);
            statsL[2 * row] = mean; statsL[2 * row + 1] = 1.f / sqrtf(var + LN_EPS); }
        if (tid < 64) cntL[tid] = 0u;
        __syncthreads();
        const int tg = wave >> 1, et = wave & 1, r32 = lane & 31, hi = lane >> 5;
        f32x16 acc = {0.f, 0.f, 0.f, 0.f, 0.f, 0.f, 0.f, 0.f, 0.f, 0.f, 0.f, 0.f, 0.f, 0.f, 0.f, 0.f};
        const float* yw = y1 + (size_t)(m0 + wave * 16) * D + 2 * lane;
        bf16_t* hw = (bf16_t*)(ws + WS_H1B) + (size_t)(m0 + wave * 16) * D + 2 * lane;
        const float* wsrc = (const float*)(ws + WS_WRP) + 4 * tid;
        const LAS float* aL = hsL + (32 * tg + r32) * P5_HSTR + 4 * hi;
        const LAS float* bL = wL + ((et * 16) * 2 + hi) * 128 + 4 * r32;
        float mean16[16], rstd16[16];
#pragma unroll
        for (int r = 0; r < 16; ++r) { mean16[r] = statsL[2 * (wave * 16 + r)]; rstd16[r] = statsL[2 * (wave * 16 + r) + 1]; }
        f32x2 yv[16]; f32x4 wq[4];
#pragma unroll
        for (int r = 0; r < 16; ++r) yv[r] = *(const GAS f32x2*)(yw + (size_t)r * D);
#pragma unroll
        for (int q = 0; q < 4; ++q) wq[q] = *(const GAS f32x4*)(wsrc + 2048 * q);
#pragma unroll 1
        for (int sl = 0; sl < 8; ++sl) {
            const f32x2 gv = *(const GAS f32x2*)(a.ln1_g + 128 * sl + 2 * lane), bv = *(const GAS f32x2*)(a.ln1_b + 128 * sl + 2 * lane);
#pragma unroll
            for (int r = 0; r < 16; ++r) { const f32x2 h = (yv[r] - mean16[r]) * rstd16[r] * gv + bv;
                *(LAS f32x2*)(hsL + (wave * 16 + r) * P5_HSTR + 2 * lane) = h; *(GAS unsigned*)(hw + (size_t)r * D + 128 * sl) = pk2(h.x, h.y); }
#pragma unroll
            for (int q = 0; q < 4; ++q) *(LAS f32x4*)(wL + 4 * tid + 2048 * q) = wq[q];
            if (sl < 7) {
#pragma unroll
                for (int r = 0; r < 16; ++r) yv[r] = *(const GAS f32x2*)(yw + (size_t)r * D + 128 * (sl + 1));
#pragma unroll
                for (int q = 0; q < 4; ++q) wq[q] = *(const GAS f32x4*)(wsrc + 8192 * (sl + 1) + 2048 * q); }
            __syncthreads();
            f32x4 av[2][4], bw[2][4];
#pragma unroll
            for (int q = 0; q < 4; ++q) { av[0][q] = *(const LAS f32x4*)(aL + 8 * q); bw[0][q] = *(const LAS f32x4*)(bL + 256 * q); }
#pragma unroll
            for (int bt = 0; bt < 4; ++bt) {
                if (bt < 3) {
#pragma unroll
                    for (int q = 0; q < 4; ++q) { av[(bt + 1) & 1][q] = *(const LAS f32x4*)(aL + 8 * (4 * (bt + 1) + q)); bw[(bt + 1) & 1][q] = *(const LAS f32x4*)(bL + 256 * (4 * (bt + 1) + q)); } }
#pragma unroll
                for (int q = 0; q < 4; ++q)
#pragma unroll
                    for (int jj = 0; jj < 4; ++jj) acc = __builtin_amdgcn_mfma_f32_32x32x2f32(av[bt & 1][q][jj], bw[bt & 1][q][jj], acc, 0, 0, 0);
                __builtin_amdgcn_sched_barrier(0);
            }
            __syncthreads();
        }
#pragma unroll
        for (int r = 0; r < 16; ++r) logitL[(32 * tg + crow(r, hi)) * 65 + 32 * et + r32] = acc[r];
        __syncthreads();
        if (wave < 2) {
            const int tok = wave * 64 + lane, m = m0 + tok;
            LAS float* row = logitL + tok * 65; LAS float* srow = logitL + 128 * 65 + tok * 65;
#pragma unroll 8
            for (int e = 0; e < 64; ++e) { const float sg = 1.f / (1.f + expf(-row[e])); srow[e] = sg; row[e] = sg + a.router_bias[e]; }
            float gs[8];
#pragma unroll
            for (int g = 0; g < 8; ++g) { float v[8];
#pragma unroll
                for (int j = 0; j < 8; ++j) v[j] = row[8 * g + j];
                const float m1 = fmaxf(fmaxf(fmaxf(v[0], v[1]), fmaxf(v[2], v[3])), fmaxf(fmaxf(v[4], v[5]), fmaxf(v[6], v[7])));
                float m2 = -INFINITY; bool seen = false;
#pragma unroll
                for (int j = 0; j < 8; ++j) { const bool is = (v[j] == m1) && !seen; seen = seen || is; m2 = is ? m2 : fmaxf(m2, v[j]); }
                gs[g] = m1 + m2; }
#pragma unroll
            for (int g = 0; g < 8; ++g) { int rk = 0;
#pragma unroll
                for (int g2 = 0; g2 < 8; ++g2) rk += (gs[g2] > gs[g] || (gs[g2] == gs[g] && g2 < g)) ? 1 : 0;
                if (rk >= 4) {
#pragma unroll
                    for (int j = 0; j < 8; ++j) row[8 * g + j] = -INFINITY; } }
            int sel[8]; float sv[8]; float ssum = 0.f;
#pragma unroll
            for (int k = 0; k < 8; ++k) { float best = -INFINITY; int bi = 0;
#pragma unroll 8
                for (int e = 0; e < 64; ++e) { const float v = row[e]; if (v > best) { best = v; bi = e; } }
                sel[k] = bi; sv[k] = srow[bi]; ssum += sv[k]; row[bi] = -INFINITY; }
            typedef int i32x4 __attribute__((ext_vector_type(4)));
            *(GAS i32x4*)((int*)(ws + WS_EIDX) + (size_t)m * 8) = (i32x4){sel[0], sel[1], sel[2], sel[3]}; *(GAS i32x4*)((int*)(ws + WS_EIDX) + (size_t)m * 8 + 4) = (i32x4){sel[4], sel[5], sel[6], sel[7]};
            f32x4 g0, g1;
#pragma unroll
            for (int k = 0; k < 4; ++k) { g0[k] = sv[k] / ssum * 2.5f; g1[k] = sv[4 + k] / ssum * 2.5f; }
            *(GAS f32x4*)((float*)(ws + WS_GATE) + (size_t)m * 8) = g0; *(GAS f32x4*)((float*)(ws + WS_GATE) + (size_t)m * 8 + 4) = g1;
#pragma unroll
            for (int k = 0; k < 8; ++k) lds_add(&cntL[sel[k]], 1u);
        }
        __syncthreads();
        if (tid < 64) ((unsigned*)(ws + WS_CNTWG))[tb * 64 + tid] = cntL[tid];
        __syncthreads();
    }
}

__device__ __forceinline__ void phase6(const Args& a, const Ctx& c) {
    unsigned char* ws = a.ws; const int tid = c.tid, lane = c.lane;
    LAS unsigned* baseL = (LAS unsigned*)c.lds;
    const unsigned* cntwg = (const unsigned*)(ws + WS_CNTWG);
    for (int tb = c.vcu; tb < 256; tb += c.G) {
        const int r = tb / TBR;
        int* tab = (int*)(ws + WS_TABLES) + r * 240;
        int* tokbuf = (int*)(ws + WS_TOKBUF) + (size_t)r * (RROWS + 256); float* gwbuf = (float*)(ws + WS_GWBUF) + (size_t)r * (RROWS + 256);
        {
            const int e = tid & 63, part = tid >> 6; int tot = 0, pre = 0; unsigned cv[TBR / 8];
#pragma unroll
            for (int j = 0; j < TBR / 8; ++j) cv[j] = cntwg[(r * TBR + part * (TBR / 8) + j) * 64 + e];
#pragma unroll
            for (int j = 0; j < TBR / 8; ++j) { tot += (int)cv[j]; if (r * TBR + part * (TBR / 8) + j < tb) pre += (int)cv[j]; }
            baseL[64 + tid] = (unsigned)tot; baseL[64 + 512 + tid] = (unsigned)pre;
        }
        __syncthreads();
        if (tid < 64) { const int e = tid; int tot = 0, pre = 0;
#pragma unroll
            for (int p8 = 0; p8 < 8; ++p8) { tot += (int)baseL[64 + 64 * p8 + e]; pre += (int)baseL[64 + 512 + 64 * p8 + e]; }
            int incl = tot, nt = (tot + 255) >> 8, incl2 = nt;
#pragma unroll
            for (int o = 1; o < 64; o <<= 1) { const int t1 = __shfl_up(incl, o), t2 = __shfl_up(incl2, o); if (lane >= o) { incl += t1; incl2 += t2; } }
            baseL[e] = (unsigned)(incl - tot + pre);
            if ((tb % TBR) == 0) { tab[e] = tot; tab[80 + e] = incl - tot; tab[160 + e] = incl2 - nt;
                if (e == 63) { tab[64] = RT; tab[80 + 64] = RROUTED; tab[160 + 64] = incl2; tab[160 + 65] = incl2 + RT / 256; } }
        }
        __syncthreads();
        for (int ai = tid; ai < 1024; ai += 512) { const int tok = tb * 128 + (ai >> 3), k = ai & 7;
            const int e = ((const int*)(ws + WS_EIDX))[(size_t)tok * 8 + k]; const unsigned slot = lds_add(&baseL[e], 1u);
            tokbuf[slot] = tok; gwbuf[slot] = ((const float*)(ws + WS_GATE))[(size_t)tok * 8 + k]; ((int*)(ws + WS_SLOTOF))[(size_t)tok * 8 + k] = (int)slot; }
        if (tid < 128) { const int tok = tb * 128 + tid; const int slot = RROUTED + (tok % RT); tokbuf[slot] = tok; gwbuf[slot] = 1.f; }
        if ((tb % TBR) == 0 && tid < 256) { tokbuf[RROWS + tid] = 0; gwbuf[RROWS + tid] = 0.f; }
        __syncthreads();
    }
}

struct GroupOrder {
    const LAS int* tab; const char* Wbase; size_t wstride; int NPN, G, c, K; const int* tok;
    __device__ __forceinline__ bool next(int i, pg8::Unit& u) const {
        const int L = i * G + c; if (L >= tab[160 + 65] * NPN) return false;
        const int tau = L / NPN, pn = L % NPN; int lo = 0, hi = 64;
        while (lo < hi) { const int mid = (lo + hi + 1) >> 1; if (tab[160 + mid] <= tau) lo = mid; else hi = mid - 1; }
        const int e = lo, j = tau - tab[160 + e];
        u.bt = Wbase + (size_t)e * wstride + (size_t)pn * 256 * K * 2; u.arow = tab[80 + e] + 256 * j; u.i0 = e; u.i1 = pn; const int rem = tab[e] - 256 * j; u.i2 = rem < 256 ? rem : 256; return true;
    }
    __device__ __forceinline__ void aoffs(const pg8::Unit& u, const int (&R)[2], const int (&C)[2], int K_, unsigned (&o0)[2], unsigned (&o1)[2]) const {
#pragma unroll
        for (int i = 0; i < 2; ++i) { int r0 = u.arow + R[i], r1 = r0 + 128; if (tok) { r0 = tok[r0]; r1 = tok[r1]; }
            o0[i] = (unsigned)(r0 * K_ + C[i]) * 2u; o1[i] = (unsigned)(r1 * K_ + C[i]) * 2u; }
    }
};
struct EpiHid {
    bf16_t* hid;
    __device__ __forceinline__ void operator()(const f32x4 (&acc)[2][2][4][2], const pg8::Unit& u, int wr, int wc, int fr, int fq) const {
        const int pn = u.i1, lim = u.i2;
#pragma unroll
        for (int ai = 0; ai < 2; ++ai)
#pragma unroll
            for (int m = 0; m < 4; ++m) { const int row = 128 * ai + 64 * wr + 16 * m + fr;
                if (row < lim) {
#pragma unroll
                    for (int bj = 0; bj < 2; ++bj) { const f32x4 g = acc[ai][bj][m][0], uu = acc[ai][bj][m][1]; f32x4 h;
#pragma unroll
                        for (int i = 0; i < 4; ++i) h[i] = g[i] * __builtin_amdgcn_rcpf(1.f + __expf(-g[i])) * uu[i];
                        u32x2 w; w.x = pk2(h[0], h[1]); w.y = pk2(h[2], h[3]);
                        *(GAS u32x2*)(hid + (size_t)(u.arow + row) * 256 + 128 * pn + 64 * bj + 16 * wc + 4 * fq) = w; } } }
    }
};
struct EpiSlot {
    bf16_t* slots; bf16_t* slots_sh; const float* gw;
    __device__ __forceinline__ void operator()(const f32x4 (&acc)[2][2][4][2], const pg8::Unit& u, int wr, int wc, int fr, int fq) const {
        const int pn = u.i1, lim = u.i2; bf16_t* const sb = u.i0 == NE ? slots_sh : slots;
        float wgt[2][4];
#pragma unroll
        for (int ai = 0; ai < 2; ++ai)
#pragma unroll
            for (int m = 0; m < 4; ++m) wgt[ai][m] = gw[u.arow + 128 * ai + 64 * wr + 16 * m + fr];
#pragma unroll
        for (int ai = 0; ai < 2; ++ai)
#pragma unroll
            for (int m = 0; m < 4; ++m) { const int row = 128 * ai + 64 * wr + 16 * m + fr;
                if (row < lim) {
#pragma unroll
                    for (int bj = 0; bj < 2; ++bj) { const f32x4 v0 = acc[ai][bj][m][0] * wgt[ai][m], v1 = acc[ai][bj][m][1] * wgt[ai][m]; u32x4 w; w.x = pk2(v0[0], v0[1]); w.y = pk2(v0[2], v0[3]); w.z = pk2(v1[0], v1[1]); w.w = pk2(v1[2], v1[3]);
                        __builtin_nontemporal_store(w, (u32x4*)(sb + (size_t)(u.arow + row) * D + pn * 256 + 128 * bj + 32 * wc + 8 * fq)); } } }
    }
};
__device__ __forceinline__ void load_tab(const Args& a, const Ctx& c, int r) {
    LAS int* tabL = (LAS int*)(c.lds + MISC_OFF + 256);
    __syncthreads();
    if (c.tid < 240) tabL[c.tid] = ((const int*)(a.ws + WS_TABLES))[r * 240 + c.tid];
    __syncthreads();
}
__device__ __forceinline__ void phase7(const Args& a, const Ctx& c, int r) {
    load_tab(a, c, r);
    GroupOrder S1{(const LAS int*)(c.lds + MISC_OFF + 256), (const char*)(a.ws + WS_WGU), (size_t)512 * D * 2, 2, c.G, c.vcu, D, (const int*)(a.ws + WS_TOKBUF) + (size_t)r * (RROWS + 256)};
    EpiHid E{(bf16_t*)((unsigned char*)a.out + OUT_HID)};
    pg8::gemm_phase(c.lds, (const char*)(a.ws + WS_H1B), D, S1, E);
}
__device__ __forceinline__ void phase8(const Args& a, const Ctx& c, int r) {
    load_tab(a, c, r);
    GroupOrder S1{(const LAS int*)(c.lds + MISC_OFF + 256), (const char*)(a.ws + WS_WD), (size_t)D * 256 * 2, 4, c.G, c.vcu, 256, nullptr};
    EpiSlot E{(bf16_t*)(a.ws + WS_SLOTS), (bf16_t*)((unsigned char*)a.out + OUT_SLOTS_SH) - (size_t)RROUTED * D, (const float*)(a.ws + WS_GWBUF) + (size_t)r * (RROWS + 256)};
    pg8::gemm_phase<EpiSlot, GroupOrder, true>(c.lds, (const char*)a.out + OUT_HID, 256, S1, E);
}
__device__ __forceinline__ void phase9(const Args& a, const Ctx& c, int r) {
    unsigned char* ws = a.ws; const int lane = c.lane; const int gw = c.vcu * 8 + c.wave, NGW = c.G * 8;
    const bf16_t* slots = (const bf16_t*)(ws + WS_SLOTS);
    const bf16_t* slots_sh = (const bf16_t*)((const unsigned char*)a.out + OUT_SLOTS_SH);
    for (int mi = gw; mi < RT; mi += NGW) { const int m = r * RT + mi;
        int sl[9];
        { const int* so = (const int*)(ws + WS_SLOTOF) + (size_t)m * 8;
#pragma unroll
          for (int k = 0; k < 8; ++k) sl[k] = so[k];
          sl[8] = mi; }
        f32x4 v[4];
        bf16_t* hrow = (bf16_t*)(ws + WS_H1B) + (size_t)m * D;
#pragma unroll
        for (int j = 0; j < 4; ++j) { const u32x2 hw = *((const GAS u32x2*)hrow + lane + 64 * j);
            v[j][0] = ALPHA * __builtin_bit_cast(float, hw.x << 16); v[j][1] = ALPHA * __builtin_bit_cast(float, hw.x & 0xffff0000u);
            v[j][2] = ALPHA * __builtin_bit_cast(float, hw.y << 16); v[j][3] = ALPHA * __builtin_bit_cast(float, hw.y & 0xffff0000u); }
#pragma unroll
        for (int k = 0; k < 9; ++k) { const GAS u32x2* sr = (const GAS u32x2*)((k == 8 ? slots_sh : slots) + (size_t)sl[k] * D) + lane;
#pragma unroll
            for (int j = 0; j < 4; ++j) { const u32x2 w = sr[64 * j];
                v[j][0] += __builtin_bit_cast(float, w.x << 16); v[j][1] += __builtin_bit_cast(float, w.x & 0xffff0000u);
                v[j][2] += __builtin_bit_cast(float, w.y << 16); v[j][3] += __builtin_bit_cast(float, w.y & 0xffff0000u); } }
        float s = 0.f;
#pragma unroll
        for (int j = 0; j < 4; ++j) s += (v[j].x + v[j].y) + (v[j].z + v[j].w);
        const float mean = wave_sum(s) * (1.f / D); float s2 = 0.f;
#pragma unroll
        for (int j = 0; j < 4; ++j) { const f32x4 d = v[j] - mean; s2 += (d.x * d.x + d.y * d.y) + (d.z * d.z + d.w * d.w); }
        const float rstd = 1.f / sqrtf(wave_sum(s2) * (1.f / D) + LN_EPS);
#pragma unroll
        for (int j = 0; j < 4; ++j) { const f32x4 gg = *((const GAS f32x4*)a.ln2_g + lane + 64 * j), b4 = *((const GAS f32x4*)a.ln2_b + lane + 64 * j); v[j] = (v[j] - mean) * rstd * gg + b4;
 }
        store_row_bf16(hrow, lane, v);
    }
}
struct EpiFinal {
    const bf16_t* h2b; const bf16_t* pp; const float* bias; float* out;
    __device__ __forceinline__ void operator()(const f32x4 (&acc)[2][2][4][2], const pg8::Unit& u, int wr, int wc, int fr, int fq) const {
        const int pm = u.i0, pn = u.i1; const int col0 = pn * 256 + 32 * wc + 4 * fq;
        f32x4 bv[2][2];
#pragma unroll
        for (int bj = 0; bj < 2; ++bj)
#pragma unroll
            for (int n = 0; n < 2; ++n) bv[bj][n] = *(const GAS f32x4*)(bias + col0 + 128 * bj + 16 * n);
#pragma unroll
        for (int ai = 0; ai < 2; ++ai)
#pragma unroll
            for (int m = 0; m < 4; ++m) { const size_t rowoff = (size_t)(pm * 256 + 128 * ai + 64 * wr + 16 * m + fr) * D + col0;
                u32x2 pw[2][2], hw[2][2];
#pragma unroll
                for (int bj = 0; bj < 2; ++bj)
#pragma unroll
                    for (int n = 0; n < 2; ++n) { pw[bj][n] = *(const GAS u32x2*)(pp + rowoff + 128 * bj + 16 * n); hw[bj][n] = *(const GAS u32x2*)(h2b + rowoff + 128 * bj + 16 * n); }
#pragma unroll
                for (int bj = 0; bj < 2; ++bj)
#pragma unroll
                    for (int n = 0; n < 2; ++n) { const f32x4 z = acc[ai][bj][m][n] + bv[bj][n]; const u32x2 p_ = pw[bj][n], h_ = hw[bj][n];
                        const float pf[4] = {__builtin_bit_cast(float, p_.x << 16), __builtin_bit_cast(float, p_.x & 0xffff0000u), __builtin_bit_cast(float, p_.y << 16), __builtin_bit_cast(float, p_.y & 0xffff0000u)};
                        const float hf[4] = {__builtin_bit_cast(float, h_.x << 16), __builtin_bit_cast(float, h_.x & 0xffff0000u), __builtin_bit_cast(float, h_.y << 16), __builtin_bit_cast(float, h_.y & 0xffff0000u)};
                        f32x4 o;
#pragma unroll
                        for (int i = 0; i < 4; ++i) o[i] = hf[i] + pf[i] * __builtin_amdgcn_rcpf(1.f + __expf(-z[i]));
                        __builtin_nontemporal_store(o, (f32x4*)(out + rowoff + 128 * bj + 16 * n)); } }
    }
};
__device__ __forceinline__ void phase10(const Args& a, const Ctx& c) {
    pg8::DenseOrder S1; S1.init(a.ws + WS_WPG, T, D, D, c.G, (int)blockIdx.x);
    EpiFinal E{(const bf16_t*)(a.ws + WS_H1B), (const bf16_t*)(a.ws + WS_PP), a.b_pg, a.out};
    pg8::gemm_phase(c.lds, (const char*)(a.ws + WS_H1B), D, S1, E);
}

constexpr int N_PHASES = 9 + 2 * NR;
__global__ void __launch_bounds__(512, 2) mega_fwd(Args a) {
    extern __shared__ __attribute__((aligned(16))) unsigned char lds_raw[];
    Ctx c; c.lds = (LAS unsigned char*)lds_raw; c.tid = threadIdx.x; c.lane = c.tid & 63; c.wave = __builtin_amdgcn_readfirstlane(c.tid >> 6);
    c.G = gridDim.x; { const int bx = blockIdx.x; c.vcu = (c.G % 8 == 0) ? (bx % 8) * (c.G / 8) + bx / 8 : bx; }
    volatile LAS unsigned* MISC = (volatile LAS unsigned*)(c.lds + MISC_OFF);
    if (c.tid < 64) MISC[c.tid] = 0u;
    __syncthreads();
    const bool one = (a.ph_hi - a.ph_lo) > 1;
    XcdBarrier bar; bar.bar = (unsigned*)(a.ws + WS_CTL) + CW_BAR; bar.x = 0; bar.st = MISC + 8;
    if (one) bar = xcd_barrier_post((unsigned*)(a.ws + WS_CTL) + CW_BAR, MISC + 8);
#ifndef PH_MASK
#define PH_MASK 0x7fffffff
#endif
#define PH(k) (((PH_MASK >> (k)) & 1) && a.ph_lo <= (k) && (k) < a.ph_hi)
#define SEAM(k) do { if (PH(k) && PH((k) + 1)) xcd_barrier(bar); } while (0)
    if (PH(0)) phase0(a, c);
    SEAM(0);
    if (PH(1)) phase1(a, c);
    SEAM(1);
    if (PH(2)) phase2(a, c);
    SEAM(2);
    if (PH(3)) phase3(a, c);
    SEAM(3);
    if (PH(4)) phase4(a, c);
    SEAM(4);
    if (PH(5)) phase5(a, c);
    SEAM(5);
    if (PH(6)) phase6(a, c);
    SEAM(6);
    for (int r = 0; r < NR; ++r) {
        const int k = 7 + 2 * r;
        if (PH(k)) { if (r > 0) phase9(a, c, r - 1); phase7(a, c, r); }
        SEAM(k);
        if (PH(k + 1)) phase8(a, c, r);
        SEAM(k + 1);
    }
    if (PH(7 + 2 * NR)) phase9(a, c, NR - 1);
    SEAM(7 + 2 * NR);
    if (PH(8 + 2 * NR)) phase10(a, c);
#undef PH
#undef SEAM
}

extern "C" void kernel_launch(void* const* d_in, const int* in_sizes, int n_in, void* d_out, int out_size, void* d_ws, size_t ws_size, hipStream_t stream) {
    static int grid = 0;
    if (grid == 0) {
        if (n_in != 27 || out_size != T * D || ws_size < WS_END) { fprintf(stderr, "kernel_launch: unexpected shapes (n_in %d out %d ws %zu)\n", n_in, out_size, ws_size); grid = -1; return; }
        int dev = 0, cus = 0, per_cu = 0;
        if (hipGetDevice(&dev) != hipSuccess || hipDeviceGetAttribute(&cus, hipDeviceAttributeMultiprocessorCount, dev) != hipSuccess) { grid = -1; return; }
        if (hipFuncSetAttribute((const void*)mega_fwd, hipFuncAttributeMaxDynamicSharedMemorySize, LDS_BYTES) != hipSuccess) { fprintf(stderr, "kernel_launch: hipFuncSetAttribute failed\n"); grid = -1; return; }
        if (hipOccupancyMaxActiveBlocksPerMultiprocessor(&per_cu, (const void*)mega_fwd, 512, LDS_BYTES) != hipSuccess || per_cu < 1) { fprintf(stderr, "kernel_launch: occupancy query says %d\n", per_cu); grid = -1; (void)hipGetLastError(); return; }
        if (cus > 256) cus = 256;
        if (T % (4 * cus * 8) != 0) { fprintf(stderr, "kernel_launch: unsupported CU count %d\n", cus); grid = -1; return; }
        grid = cus;
    }
    if (grid < 0) return;
    (void)hipMemsetAsync((char*)d_ws + WS_CTL, 0, CTL_ZERO_BYTES, stream);
    Args a{};
    a.x = (const float*)d_in[0]; a.p = (const float*)d_in[1]; a.positions = (const int*)d_in[2]; a.ln_emb_g = (const float*)d_in[3]; a.ln_emb_b = (const float*)d_in[4];
    a.w_in = (const float*)d_in[5]; a.w_o = (const float*)d_in[6]; a.lq1 = (const float*)d_in[7]; a.lk1 = (const float*)d_in[8]; a.lq2 = (const float*)d_in[9]; a.lk2 = (const float*)d_in[10];
    a.subln_g = (const float*)d_in[11]; a.ln1_g = (const float*)d_in[12]; a.ln1_b = (const float*)d_in[13]; a.w_router = (const float*)d_in[14]; a.router_bias = (const float*)d_in[15];
    a.w_eg = (const float*)d_in[16]; a.w_eu = (const float*)d_in[17]; a.w_ed = (const float*)d_in[18]; a.w_sg = (const float*)d_in[19]; a.w_su = (const float*)d_in[20]; a.w_sd = (const float*)d_in[21];
    a.ln2_g = (const float*)d_in[22]; a.ln2_b = (const float*)d_in[23]; a.w_pg = (const float*)d_in[24]; a.b_pg = (const float*)d_in[25]; a.w_pp = (const float*)d_in[26];
    a.out = (float*)d_out; a.ws = (unsigned char*)d_ws;
#if MK_N_LAUNCHES == 1
    a.ph_lo = 0; a.ph_hi = N_PHASES;
    void* args[] = {&a};
    hipError_t e = hipLaunchCooperativeKernel((const void*)mega_fwd, dim3(grid), dim3(512), args, LDS_BYTES, stream);
    if (e != hipSuccess) fprintf(stderr, "kernel_launch: cooperative launch failed: %s\n", hipGetErrorString(e));
#else
    for (int ph = 0; ph < N_PHASES; ++ph) { a.ph_lo = ph; a.ph_hi = ph + 1; hipLaunchKernelGGL(mega_fwd, dim3(grid), dim3(512), LDS_BYTES, stream, a); }
#endif
}
```

```cpp
#include <hip/hip_runtime.h>
#include <cstdio>
#include <cstdint>

#define LAS __attribute__((address_space(3)))
#define GAS __attribute__((address_space(1)))
typedef unsigned short bf16_t;
typedef short bf16x8 __attribute__((ext_vector_type(8)));
typedef float f32x4 __attribute__((ext_vector_type(4)));
typedef float f32x2 __attribute__((ext_vector_type(2)));
typedef float f32x16 __attribute__((ext_vector_type(16)));
typedef unsigned u32x4 __attribute__((ext_vector_type(4)));
typedef unsigned u32x2 __attribute__((ext_vector_type(2)));

#ifndef MK_N_LAUNCHES
#define MK_N_LAUNCHES 1
#endif

constexpr int NB = 4, S = 8192, T = NB * S, D = 1024;
constexpr int NPROJ = 3840;
constexpr int NE = 64, NEX = 65;
constexpr int NR = 2, RT = T / NR, TBR = RT / 128;
constexpr int RROUTED = RT * 8, RROWS = RROUTED + RT;
constexpr float QSCALE = 0.125f * 1.4426950408889634f;
constexpr float WSCALE = 0.04419417382415922f;
constexpr float ALPHA = 1.189207115002721f;
constexpr float LAMBDA_INIT = 0.2f;
constexpr float LN_EPS = 1e-5f, RMS_EPS = 1e-5f;
constexpr float NEGBIG = -1.0e30f;

constexpr size_t MiB = 1u << 20;
constexpr size_t WS_CTL = 0, CTL_ZERO_BYTES = 256 * 1024;
constexpr size_t WS_STATS0 = 1 * MiB;
constexpr size_t WS_WRP = 1 * MiB + 512 * 1024;
constexpr size_t WS_IW = 2 * MiB;
constexpr size_t WS_CNTWG = 3 * MiB;
constexpr size_t WS_TABLES = 3 * MiB + 512 * 1024;
constexpr size_t WS_UTAB = WS_TABLES + 8192;
constexpr size_t WS_EIDX = 4 * MiB;
constexpr size_t WS_GATE = 5 * MiB;
constexpr size_t WS_SLOTOF = 6 * MiB;
constexpr size_t WS_TOKBUF = 7 * MiB;
constexpr size_t WS_GWBUF = 9 * MiB;
constexpr size_t WS_YST = 12 * MiB;
constexpr size_t WS_IK = 12 * MiB;
constexpr size_t WS_WIN = 16 * MiB;
constexpr size_t WS_WO = 24 * MiB;
constexpr size_t WS_WPG = 26 * MiB;
constexpr size_t WS_WPP = 28 * MiB;
constexpr size_t WS_WGU = 29 * MiB;
constexpr size_t WS_WD = 94 * MiB;
constexpr size_t WS_CS = 127 * MiB;
constexpr size_t WS_H0B = 136 * MiB;
constexpr size_t WS_AO = 136 * MiB;
constexpr size_t WS_PB = 200 * MiB;
constexpr size_t WS_AQ = 216 * MiB, WS_AK = 248 * MiB, WS_AVT = 280 * MiB, WS_IQ = 312 * MiB, WS_BQ = 344 * MiB, WS_BK = 376 * MiB, WS_BVT = 408 * MiB;
constexpr size_t WS_MASK = 440 * MiB;
constexpr size_t WS_STASH = 457 * MiB;
constexpr size_t WS_Y1 = 216 * MiB;
constexpr size_t WS_H1B = 127 * MiB;
constexpr size_t WS_SLOTS = 191 * MiB;
constexpr size_t OUT_HID = 0, OUT_SLOTS_SH = 80 * MiB;
constexpr size_t WS_PP = 447 * MiB;
constexpr size_t WS_IXA = 127 * MiB, WS_IXB = 457 * MiB; constexpr int IX_NA = 146;
constexpr size_t WS_END = 512 * MiB;

constexpr int CW_BAR = 1024;

__device__ __forceinline__ unsigned f2bf(float f) { unsigned u = __builtin_bit_cast(unsigned, f); return (u + 0x7fffu + ((u >> 16) & 1u)) >> 16; }
typedef __bf16 bf16x2_t __attribute__((ext_vector_type(2)));
__device__ __forceinline__ unsigned pk2(float lo, float hi) { f32x2 v = {lo, hi}; bf16x2_t b = __builtin_convertvector(v, bf16x2_t); return __builtin_bit_cast(unsigned, b); }
__device__ __forceinline__ float bf2f(unsigned short b) { return __builtin_bit_cast(float, (unsigned)b << 16); }
template <int CTRL> __device__ __forceinline__ float dppf(float v) { return __builtin_bit_cast(float, __builtin_amdgcn_update_dpp(0, __builtin_bit_cast(int, v), CTRL, 0xf, 0xf, true)); }
__device__ __forceinline__ float rdlane(float v, int l) { return __builtin_bit_cast(float, __builtin_amdgcn_readlane(__builtin_bit_cast(int, v), l)); }
__device__ __forceinline__ float wave_sum(float v) {
    v += dppf<0xB1>(v); v += dppf<0x4E>(v); v += dppf<0x124>(v); v += dppf<0x128>(v);
    return (rdlane(v, 0) + rdlane(v, 16)) + (rdlane(v, 32) + rdlane(v, 48));
}
__device__ __forceinline__ float wave_max(float v) {
    v = fmaxf(v, dppf<0xB1>(v)); v = fmaxf(v, dppf<0x4E>(v)); v = fmaxf(v, dppf<0x124>(v)); v = fmaxf(v, dppf<0x128>(v));
    return fmaxf(fmaxf(rdlane(v, 0), rdlane(v, 16)), fmaxf(rdlane(v, 32), rdlane(v, 48)));
}
__device__ __forceinline__ float max8(float v) {
    v = fmaxf(v, dppf<0xB1>(v)); v = fmaxf(v, dppf<0x4E>(v)); return fmaxf(v, dppf<0x141>(v));
}
__device__ __forceinline__ int crow(int r, int hi) { return (r & 3) + 8 * (r >> 2) + 4 * hi; }
__device__ __forceinline__ int swz16(int s) { return (s & ~12) | ((s & 4) << 1) | ((s & 8) >> 1); }
__device__ __forceinline__ unsigned lds_add(LAS unsigned* p, unsigned v) { return __hip_atomic_fetch_add(p, v, __ATOMIC_RELAXED, __HIP_MEMORY_SCOPE_WORKGROUP); }
__device__ __forceinline__ void swap32(float v, float& own_or_partner0, float& own_or_partner1) { float a = v, b = v;
    asm volatile("s_nop 1\n\tv_permlane32_swap_b32 %0, %1" : "+v"(a), "+v"(b)); own_or_partner0 = a; own_or_partner1 = b; }
__device__ __forceinline__ void swap16(float v, float& own_or_partner0, float& own_or_partner1) { float a = v, b = v;
    asm volatile("s_nop 1\n\tv_permlane16_swap_b32 %0, %1" : "+v"(a), "+v"(b)); own_or_partner0 = a; own_or_partner1 = b; }
__device__ __forceinline__ float xsum32(float v) { float a, b; swap32(v, a, b); return a + b; }
__device__ __forceinline__ float xsum16(float v) { float a, b; swap16(v, a, b); return a + b; }
__device__ __forceinline__ float xmax32(float v) { float a, b; swap32(v, a, b); return fmaxf(a, b); }
#define LDS_WAIT() asm volatile("s_waitcnt lgkmcnt(0)" ::: "memory")
#define VM_WAIT() asm volatile("s_waitcnt vmcnt(0)" ::: "memory")

namespace pg8 {
constexpr int BM = 256, BK = 64, HALF = 128, HTB = HALF * BK * 2, STAGE_BYTES = 8 * HTB;
__host__ __device__ __forceinline__ int lds_byte(int r, int c) { const int st = (r >> 4) * 2 + (c >> 5), rr = r & 15, cc = c & 31, ob = rr * 64 + cc * 2; return st * 1024 + (ob ^ (((ob >> 9) & 1) << 5)); }
__host__ __device__ __forceinline__ void stage_rc(int b, int& R, int& C) { const int st = b / 1024, sb = b % 1024, swz = sb ^ (((sb >> 9) & 1) << 5); R = (st >> 1) * 16 + swz / 64; C = (st & 1) * 32 + (swz % 64) / 2; }

struct Unit { const char* bt; int arow; int i0, i1, i2; };

template <class Epi, class Sched, int PERM = 0, bool PRE = false, int NBJ = 2>
__device__ __forceinline__ void gemm_phase(LAS unsigned char* lds, const char* Abase, const int K, const Sched& S, const Epi& E) {
    int tid_ = threadIdx.x; asm volatile("" : "+v"(tid_));
    const int tid = tid_, wid = __builtin_amdgcn_readfirstlane(tid >> 6), lane = tid & 63, wr = wid >> 2, wc = wid & 3, fr = lane & 15, fq = lane >> 4;
    const int nt = K / BK;
    int Rr[2], Cc[2]; unsigned voffB[2];
#pragma unroll
    for (int i = 0; i < 2; ++i) { stage_rc(tid * 16 + i * 8192, Rr[i], Cc[i]); const int rho = Rr[i] & 31; const int Rb = PERM == 2 ? (64 * (Rr[i] >> 5) + 16 * ((rho & 15) >> 2) + 4 * (rho >> 4) + (rho & 3)) : PERM == 1 ? ((Rr[i] & ~31) + 8 * ((rho & 15) >> 2) + 4 * (rho >> 4) + (rho & 3)) : Rr[i];
        voffB[i] = (unsigned)(Rb * K + Cc[i]) * 2u; }
    const size_t kstep = (size_t)(BK * 2);
    const size_t hstepB = (size_t)(PERM == 2 ? 8 : HALF) * K * 2;
    const unsigned ldsw = (unsigned)wid * 1024u;
    const int aoff = lds_byte(wr * 64 + fr, fq * 8), boff = lds_byte(wc * 32 + fr, fq * 8);
#define PG8_SA(b, h) (((b) * 2 + (h)) * HTB)
#define PG8_SB(b, h) ((4 + (b) * 2 + (h)) * HTB)
#define PG8_STAGE_B(bufoff, gbase) do { _Pragma("unroll") for (int _i = 0; _i < 2; ++_i) \
        __builtin_amdgcn_global_load_lds((const unsigned*)((const char*)(gbase) + voffB[_i]), (LAS unsigned*)(lds + (bufoff) + ldsw + _i * 8192), 16, 0, 0); } while (0)
#define PG8_STAGE_A(bufoff, kt, off) do { _Pragma("unroll") for (int _i = 0; _i < 2; ++_i) \
        __builtin_amdgcn_global_load_lds((const unsigned*)(Abase + (kt) + (off)[_i]), (LAS unsigned*)(lds + (bufoff) + ldsw + _i * 8192), 16, 0, 0); } while (0)
#define PG8_LDA(dst, b, h) do { _Pragma("unroll") for (int m = 0; m < 4; ++m) _Pragma("unroll") for (int k = 0; k < 2; ++k) dst[m][k] = *(const LAS bf16x8*)(lds + PG8_SA(b, h) + aoff + m * 2048 + k * 1024); } while (0)
#define PG8_LDB(dst, b, h) do { _Pragma("unroll") for (int n = 0; n < 2; ++n) _Pragma("unroll") for (int k = 0; k < 2; ++k) dst[n][k] = *(const LAS bf16x8*)(lds + PG8_SB(b, h) + boff + n * 2048 + k * 1024); } while (0)
#define PG8_MMA(ai, bj, At, Bt) do { __builtin_amdgcn_s_setprio(1); _Pragma("unroll") for (int m = 0; m < 4; ++m) _Pragma("unroll") for (int n = 0; n < 2; ++n) _Pragma("unroll") for (int k = 0; k < 2; ++k) \
        acc[ai][bj][m][n] = __builtin_amdgcn_mfma_f32_16x16x32_bf16(Bt[n][k], At[m][k], acc[ai][bj][m][n], 0, 0, 0); __builtin_amdgcn_s_setprio(0); } while (0)
#define PG8_WAIT_V(n) asm volatile("s_waitcnt vmcnt(" #n ")" ::: "memory")
#define PG8_WAIT_L(n) asm volatile("s_waitcnt lgkmcnt(" #n ")" ::: "memory")
#define PG8_BAR __builtin_amdgcn_s_barrier()
#define PG8_SCHED __builtin_amdgcn_sched_barrier(0)
    Unit cur, nxt; int ui = 0;
    if (!S.next(0, cur)) return;
    f32x4 acc[2][2][4][2];
#pragma unroll
    for (int a = 0; a < 2; ++a)
#pragma unroll
        for (int b = 0; b < 2; ++b)
#pragma unroll
            for (int m = 0; m < 4; ++m)
#pragma unroll
                for (int n = 0; n < 2; ++n) acc[a][b][m][n] = (f32x4){0.f, 0.f, 0.f, 0.f};
    bf16x8 At[4][2], B0[2][2], B1[2][2];
    unsigned oC0[2], oC1[2], oN0[2], oN1[2];
    S.aoffs(cur, Rr, Cc, K, oC0, oC1);
    const char* cB = cur.bt;
    PG8_STAGE_B(PG8_SB(0, 0), cB); PG8_STAGE_B(PG8_SB(0, 1), cB + hstepB); PG8_STAGE_A(PG8_SA(0, 0), 0, oC0); PG8_STAGE_A(PG8_SA(0, 1), 0, oC1);
    if (wr == 1) PG8_BAR;
    PG8_WAIT_V(2); PG8_BAR;
    PG8_STAGE_B(PG8_SB(1, 0), cB + kstep); PG8_STAGE_A(PG8_SA(1, 0), kstep, oC0); PG8_STAGE_B(PG8_SB(1, 1), cB + hstepB + kstep);
    PG8_WAIT_V(6); PG8_BAR;
    for (;;) {
        if constexpr (PRE) { if (wid < 4) __builtin_amdgcn_global_load_lds((const unsigned*)(E.rowf + cur.arow + wid * 64 + lane), (LAS unsigned*)(lds + 131072 + (ui & 1) * 1024 + wid * 256), 4, 0, 0); }
        const bool has_next = S.next(ui + 1, nxt);
        const char* nB = has_next ? nxt.bt : cB;
        if (has_next) S.aoffs(nxt, Rr, Cc, K, oN0, oN1); else { oN0[0] = oC0[0]; oN0[1] = oC0[1]; oN1[0] = oC1[0]; oN1[1] = oC1[1]; }
#pragma unroll 1
        for (int t = 0; t < nt; t += 2) {
            const bool last = (t == nt - 2);
            const size_t kt1 = (size_t)(t + 1) * kstep;
            const size_t kt2 = last ? 0 : (size_t)(t + 2) * kstep, kt3 = kt2 + kstep;
            const char* b2 = last ? nB : cB + (size_t)(t + 2) * kstep; const char* b3 = b2 + kstep;
            unsigned p0[2], p1[2];
            p0[0] = last ? oN0[0] : oC0[0]; p0[1] = last ? oN0[1] : oC0[1]; p1[0] = last ? oN1[0] : oC1[0]; p1[1] = last ? oN1[1] : oC1[1];
            PG8_LDB(B0, 0, 0); if (NBJ == 2) PG8_LDB(B1, 0, 1); PG8_SCHED; PG8_LDA(At, 0, 0); PG8_STAGE_A(PG8_SA(1, 1), kt1, oC1);
            PG8_WAIT_V(8); PG8_WAIT_L(0); PG8_BAR; PG8_MMA(0, 0, At, B0); if (NBJ == 2) PG8_MMA(0, 1, At, B1); PG8_BAR; PG8_SCHED;
            PG8_LDA(At, 0, 1); PG8_STAGE_B(PG8_SB(0, 0), b2); PG8_STAGE_B(PG8_SB(0, 1), b2 + hstepB); PG8_STAGE_A(PG8_SA(0, 0), kt2, p0);
            PG8_WAIT_V(8); PG8_WAIT_L(0); PG8_BAR; PG8_MMA(1, 0, At, B0); if (NBJ == 2) PG8_MMA(1, 1, At, B1); PG8_BAR; PG8_SCHED;
            PG8_LDB(B0, 1, 0); if (NBJ == 2) PG8_LDB(B1, 1, 1); PG8_SCHED; PG8_LDA(At, 1, 0); PG8_STAGE_A(PG8_SA(0, 1), kt2, p1);
            PG8_WAIT_V(8); PG8_WAIT_L(0); PG8_BAR; PG8_MMA(0, 0, At, B0); if (NBJ == 2) PG8_MMA(0, 1, At, B1); PG8_BAR; PG8_SCHED;
            PG8_LDA(At, 1, 1); PG8_STAGE_B(PG8_SB(1, 0), b3); PG8_STAGE_B(PG8_SB(1, 1), b3 + hstepB); PG8_STAGE_A(PG8_SA(1, 0), kt3, p0);
            PG8_WAIT_V(8); PG8_WAIT_L(0); PG8_BAR; PG8_MMA(1, 0, At, B0); if (NBJ == 2) PG8_MMA(1, 1, At, B1); PG8_BAR; PG8_SCHED;
        }
        if (wr == 0) PG8_BAR;
        { int fr_ = fr, fq_ = fq; asm volatile("" : "+v"(fr_), "+v"(fq_)); if constexpr (PRE) E(acc, cur, wr, wc, fr_, fq_, (const LAS float*)(lds + 131072 + (ui & 1) * 1024)); else E(acc, cur, wr, wc, fr_, fq_); }
        if (!has_next) break;
#pragma unroll
        for (int a = 0; a < 2; ++a)
#pragma unroll
            for (int b = 0; b < 2; ++b)
#pragma unroll
                for (int m = 0; m < 4; ++m)
#pragma unroll
                    for (int n = 0; n < 2; ++n) acc[a][b][m][n] = (f32x4){0.f, 0.f, 0.f, 0.f};
        cur = nxt; cB = nB; oC0[0] = oN0[0]; oC0[1] = oN0[1]; oC1[0] = oN1[0]; oC1[1] = oN1[1]; ++ui;
        if (wr == 1) PG8_BAR;
    }
    PG8_WAIT_V(0);
    PG8_BAR;
#undef PG8_SA
#undef PG8_SB
#undef PG8_STAGE_A
#undef PG8_STAGE_B
#undef PG8_LDA
#undef PG8_LDB
#undef PG8_MMA
#undef PG8_WAIT_V
#undef PG8_WAIT_L
#undef PG8_BAR
#undef PG8_SCHED
}

struct DenseOrder {
    const char* Bt; int K; int nM, nN, nwg, G, c;
    __device__ void init(const void* Bt_, int M, int N, int K_, int G_, int c_) { Bt = (const char*)Bt_; K = K_; nM = M / BM; nN = N / BM; nwg = nM * nN; G = G_; c = c_; }
    __device__ __forceinline__ bool next(int i, Unit& u) const {
        const long L = (long)i * G + c; if (L >= nwg) return false;
        int wgid = (int)L; { const int q = nwg / 8, r = nwg % 8, xcd = wgid % 8, off = wgid / 8; wgid = (xcd < r ? xcd * (q + 1) : r * (q + 1) + (xcd - r) * q) + off; }
        const int nig = 8 * nN, gid = wgid / nig, fm = gid * 8, gsz = (nM - fm) < 8 ? (nM - fm) : 8;
        const int pm = fm + ((wgid % nig) % gsz), pn = (wgid % nig) / gsz;
        u.bt = Bt + (size_t)pn * BM * K * 2; u.arow = pm * BM; u.i0 = pm; u.i1 = pn; u.i2 = 0; return true;
    }
    __device__ __forceinline__ void aoffs(const Unit& u, const int (&R)[2], const int (&C)[2], int K_, unsigned (&o0)[2], unsigned (&o1)[2]) const {
#pragma unroll
        for (int i = 0; i < 2; ++i) { o0[i] = (unsigned)((u.arow + R[i]) * K_ + C[i]) * 2u; o1[i] = (unsigned)((u.arow + HALF + R[i]) * K_ + C[i]) * 2u; }
    }
};
}

#define XB_TMO      128
#define XB_XCNT(j)  (256  + 64 * (j))
#define XB_XSUB(j)  (1280 + 64 * (j))
#define XB_XGEN(j)  (2304 + 64 * (j))
#define XB_TOP      3328
#define XB_TOPGEN   3392
#define XCD_BAR_WORDS 3456
#define XB_SPIN_CAP (1u << 20)
__device__ __forceinline__ unsigned xb_ld(unsigned* p)              { return __hip_atomic_load(p, __ATOMIC_RELAXED, __HIP_MEMORY_SCOPE_AGENT); }
__device__ __forceinline__ unsigned xb_add(unsigned* p, unsigned v) { return __hip_atomic_fetch_add(p, v, __ATOMIC_RELAXED, __HIP_MEMORY_SCOPE_AGENT); }
__device__ __forceinline__ unsigned xb_xcc_id() { return (unsigned)__builtin_amdgcn_s_getreg((3 << 11) | 20) & 0xFu; }
#define XB_SPIN(cond, bar) do { unsigned _sp = 0; while (cond) { __builtin_amdgcn_s_sleep(1); \
    if ((++_sp & 255u) == 0u) { if (xb_ld(&(bar)[XB_TMO])) break; if (_sp > XB_SPIN_CAP) { atomicAdd(&(bar)[XB_TMO], 1u); break; } } } } while (0)
struct XcdBarrier { unsigned* bar; unsigned x; volatile LAS unsigned* st; };
__device__ __forceinline__ XcdBarrier xcd_barrier_post(unsigned* bar, volatile LAS unsigned* st) {
    XcdBarrier b; b.bar = bar; b.x = xb_xcc_id(); b.st = st;
    if (threadIdx.x == 0) (void)xb_add(&bar[XB_XCNT(b.x)], 1u);
    return b;
}
__device__ __forceinline__ void xcd_barrier_complete(unsigned* bar, unsigned x, unsigned& nloc, unsigned& nx) {
    const unsigned G = gridDim.x * gridDim.y * gridDim.z;
    unsigned sum, cnt, mine, sp = 0u;
    for (;;) {
        sum = 0u; cnt = 0u; mine = 0u; unsigned cc[16];
#pragma unroll
        for (unsigned j = 0; j < 16; ++j) cc[j] = xb_ld(&bar[XB_XCNT(j)]);
        asm volatile("" : "+v"(cc[0]), "+v"(cc[1]), "+v"(cc[2]), "+v"(cc[3]), "+v"(cc[4]), "+v"(cc[5]), "+v"(cc[6]), "+v"(cc[7]), "+v"(cc[8]), "+v"(cc[9]), "+v"(cc[10]), "+v"(cc[11]), "+v"(cc[12]), "+v"(cc[13]), "+v"(cc[14]), "+v"(cc[15]));
#pragma unroll
        for (unsigned j = 0; j < 16; ++j) { const unsigned c = cc[j]; sum += c; cnt += (c > 0u) ? 1u : 0u; mine = (j == x) ? c : mine; }
        if (sum == G) break;
        __builtin_amdgcn_s_sleep(1);
        if ((++sp & 255u) == 0u) { if (xb_ld(&bar[XB_TMO])) break; if (sp > XB_SPIN_CAP) { atomicAdd(&bar[XB_TMO], 1u); break; } }
    }
    nloc = mine > 0u ? mine : 1u; nx = cnt > 0u ? cnt : 1u;
}
__device__ __forceinline__ void xcd_barrier(const XcdBarrier& b) {
    asm volatile("s_waitcnt vmcnt(0)" ::: "memory");
    __syncthreads();
    if (threadIdx.x == 0) {
        unsigned* bar = b.bar;
        __builtin_amdgcn_s_waitcnt(0);
        unsigned nloc = b.st[0], nx = b.st[1];
        if (nloc == 0u) { xcd_barrier_complete(bar, b.x, nloc, nx); b.st[0] = nloc; b.st[1] = nx; }
        const unsigned old = xb_add(&bar[XB_XSUB(b.x)], 1u);
        const unsigned gen = old / nloc;
        if (old + 1u == (gen + 1u) * nloc) {
            __builtin_amdgcn_fence(__ATOMIC_RELEASE, "agent");
            asm volatile("s_waitcnt vmcnt(0)" ::: "memory");
            const unsigned og = xb_add(&bar[XB_TOP], 1u);
            const unsigned tg = og / nx;
            if (og + 1u == (tg + 1u) * nx) xb_add(&bar[XB_TOPGEN], 1u);
            else XB_SPIN(xb_ld(&bar[XB_TOPGEN]) == tg, bar);
            __builtin_amdgcn_fence(__ATOMIC_ACQUIRE, "agent");
            xb_add(&bar[XB_XGEN(b.x)], 1u);
            asm volatile("s_waitcnt vmcnt(0)" ::: "memory");
        } else {
            XB_SPIN(xb_ld(&bar[XB_XGEN(b.x)]) == gen, bar);
            __builtin_amdgcn_fence(__ATOMIC_ACQUIRE, "agent");
            asm volatile("s_waitcnt vmcnt(0)" ::: "memory");
        }
    }
    __syncthreads();
}

constexpr int RING_BYTES = 131072;
constexpr int MISC_OFF = 143360;
constexpr int LDS_BYTES = 147456;

struct Args {
    const float* x; const float* p; const int* positions; const float* ln_emb_g; const float* ln_emb_b; const float* w_in; const float* w_o;
    const float* lq1; const float* lk1; const float* lq2; const float* lk2; const float* subln_g; const float* ln1_g; const float* ln1_b;
    const float* w_router; const float* router_bias; const float* w_eg; const float* w_eu; const float* w_ed; const float* w_sg; const float* w_su; const float* w_sd;
    const float* ln2_g; const float* ln2_b; const float* w_pg; const float* b_pg; const float* w_pp;
    float* out; unsigned char* ws; int ph_lo, ph_hi;
};

struct Ctx {
    LAS unsigned char* lds; int tid, lane, wave, vcu, G;
};

template <class ColMap>
__device__ __forceinline__ void p0_transpose_item(const float* W, int K, int N, bf16_t* WT, int nprime_cnt, LAS float* scr, int item, int lane, const ColMap& cm) {
    const int nblk = nprime_cnt / 32, kb = item / nblk, nb = item % nblk, k0 = 64 * kb, n0 = 32 * nb;
    const int sc = cm(n0 + (lane & 31)), scc = sc < 0 ? 0 : sc;
#pragma unroll 8
    for (int i = 0; i < 32; ++i) { const int kk = 2 * i + (lane >> 5); const float v = __builtin_nontemporal_load(W + (size_t)(k0 + kk) * N + scc);
        scr[kk * 33 + (lane & 31)] = sc >= 0 ? v : 0.f; }
    LDS_WAIT(); asm volatile("" ::: "memory");
    const int c = lane & 7;
#pragma unroll
    for (int j = 0; j < 4; ++j) { const int n = (lane >> 3) + 8 * j; const LAS float* s = scr + (8 * c) * 33 + n;
        u32x4 o; o.x = pk2(s[0 * 33], s[1 * 33]); o.y = pk2(s[2 * 33], s[3 * 33]); o.z = pk2(s[4 * 33], s[5 * 33]); o.w = pk2(s[6 * 33], s[7 * 33]);
        *(GAS u32x4*)(WT + (size_t)(n0 + n) * K + k0 + 8 * c) = o; }
    LDS_WAIT(); asm volatile("" ::: "memory");
}
__device__ __forceinline__ int seg_d(int q) { return 16 * ((q >> 5) & 1) + 32 * ((q >> 4) & 1) + (q & 15); }
struct MapWin { __device__ int operator()(int n) const { const int seg = n >> 6, d = seg_d(n & 63);
        if (seg < 33) return 64 * seg + d; if (seg < 57) return 64 * seg + d + 8; if (seg == 57) return d < 8 ? 2112 + d : -1; return -1; } };
struct MapId { __device__ int operator()(int n) const { return n; } };

__device__ __forceinline__ void ln_row(const float* xrow, const float* g, const float* bb, int lane, f32x4 (&v)[4], float& mean, float& rstd) {
    const GAS f32x4* xr = (const GAS f32x4*)xrow + lane; float s = 0.f;
#pragma unroll
    for (int j = 0; j < 4; ++j) { v[j] = xr[64 * j]; s += (v[j].x + v[j].y) + (v[j].z + v[j].w); }
    mean = wave_sum(s) * (1.f / D); float s2 = 0.f;
#pragma unroll
    for (int j = 0; j < 4; ++j) { const f32x4 d = v[j] - mean; s2 += (d.x * d.x + d.y * d.y) + (d.z * d.z + d.w * d.w); }
    rstd = 1.f / sqrtf(wave_sum(s2) * (1.f / D) + LN_EPS);
#pragma unroll
    for (int j = 0; j < 4; ++j) { const f32x4 gg = *((const GAS f32x4*)g + lane + 64 * j), b4 = *((const GAS f32x4*)bb + lane + 64 * j); v[j] = (v[j] - mean) * rstd * gg + b4; }
}
template <bool NT = false>
__device__ __forceinline__ void ln_rows4(const float* const (&xrow)[4], const float* g, const float* bb, int lane, f32x4 (&v)[4][4], float (&mean)[4], float (&rstd)[4]) {
#pragma unroll
    for (int r = 0; r < 4; ++r) { const GAS f32x4* xr = (const GAS f32x4*)xrow[r] + lane;
#pragma unroll
        for (int j = 0; j < 4; ++j) v[r][j] = NT ? __builtin_nontemporal_load((const f32x4*)(xr + 64 * j)) : xr[64 * j]; }
#pragma unroll
    for (int r = 0; r < 4; ++r) { float s = 0.f;
#pragma unroll
        for (int j = 0; j < 4; ++j) s += (v[r][j].x + v[r][j].y) + (v[r][j].z + v[r][j].w);
        mean[r] = wave_sum(s) * (1.f / D); float s2 = 0.f;
#pragma unroll
        for (int j = 0; j < 4; ++j) { const f32x4 d = v[r][j] - mean[r]; s2 += (d.x * d.x + d.y * d.y) + (d.z * d.z + d.w * d.w); }
        rstd[r] = 1.f / sqrtf(wave_sum(s2) * (1.f / D) + LN_EPS); }
#pragma unroll
    for (int j = 0; j < 4; ++j) { const f32x4 gg = *((const GAS f32x4*)g + lane + 64 * j), b4 = *((const GAS f32x4*)bb + lane + 64 * j);
#pragma unroll
        for (int r = 0; r < 4; ++r) v[r][j] = (v[r][j] - mean[r]) * rstd[r] * gg + b4; }
}
__device__ __forceinline__ void store_row_bf16(bf16_t* orow, int lane, const f32x4 (&v)[4]) {
    GAS u32x2* o8 = (GAS u32x2*)orow + lane;
#pragma unroll
    for (int j = 0; j < 4; ++j) { u32x2 w; w.x = pk2(v[j].x, v[j].y); w.y = pk2(v[j].z, v[j].w); o8[64 * j] = w; }
}

__device__ __forceinline__ void phase0(const Args& a, const Ctx& c) {
    LAS float* scr = (LAS float*)(c.lds + c.wave * 16384);
    unsigned char* ws = a.ws;
    const int gw = c.vcu * 8 + c.wave, NGW = c.G * 8;
    constexpr int I_IN = 16 * (NPROJ / 32), I_O = 16 * 32, I_PG = 16 * 32, I_PP = 4 * 32, I_GU = 16 * 16, I_D = 4 * 32;
    constexpr int NITEMS = I_IN + I_O + I_PG + I_PP + NEX * (I_GU + I_D);
    for (int it = gw; it < NITEMS; it += NGW) {
        int r = it;
        if (r < I_IN) { p0_transpose_item(a.w_in, D, 3656, (bf16_t*)(ws + WS_WIN), NPROJ, scr, r, c.lane, MapWin()); continue; } r -= I_IN;
        if (r < I_O) { p0_transpose_item(a.w_o, D, D, (bf16_t*)(ws + WS_WO), D, scr, r, c.lane, MapId()); continue; } r -= I_O;
        if (r < I_PG) { p0_transpose_item(a.w_pg, D, D, (bf16_t*)(ws + WS_WPG), D, scr, r, c.lane, MapId()); continue; } r -= I_PG;
        if (r < I_PP) { p0_transpose_item(a.w_pp, 256, D, (bf16_t*)(ws + WS_WPP), D, scr, r, c.lane, MapId()); continue; } r -= I_PP;
        const int e = r / (I_GU + I_D); r -= e * (I_GU + I_D);
        if (r < I_GU) {
            const float* wg = e < NE ? a.w_eg + (size_t)e * D * 256 : a.w_sg; const float* wu = e < NE ? a.w_eu + (size_t)e * D * 256 : a.w_su;
            bf16_t* WT = (bf16_t*)(ws + WS_WGU) + (size_t)e * 512 * D;
            const int nblk = 512 / 32, kb = r / nblk, nb = r % nblk, k0 = 64 * kb, n0 = 32 * nb; const int lane = c.lane;
            const int q = lane & 31; const float* src = (q < 16) ? wg : wu; const int sc = 16 * nb + (q & 15);
#pragma unroll 8
            for (int i = 0; i < 32; ++i) { const int kk = 2 * i + (lane >> 5); scr[kk * 33 + q] = __builtin_nontemporal_load(src + (size_t)(k0 + kk) * 256 + sc); }
            LDS_WAIT(); asm volatile("" ::: "memory");
            const int cc = lane & 7;
#pragma unroll
            for (int j = 0; j < 4; ++j) { const int n = (lane >> 3) + 8 * j; const LAS float* s = scr + (8 * cc) * 33 + n;
                u32x4 o; o.x = pk2(s[0 * 33], s[1 * 33]); o.y = pk2(s[2 * 33], s[3 * 33]); o.z = pk2(s[4 * 33], s[5 * 33]); o.w = pk2(s[6 * 33], s[7 * 33]);
                *(GAS u32x4*)(WT + (size_t)(n0 + n) * D + k0 + 8 * cc) = o; }
            LDS_WAIT(); asm volatile("" ::: "memory");
            continue;
        }
        r -= I_GU;
        { const float* wd = e < NE ? a.w_ed + (size_t)e * 256 * D : a.w_sd; p0_transpose_item(wd, 256, D, (bf16_t*)(ws + WS_WD) + (size_t)e * D * 256, D, scr, r, c.lane, MapId()); }
    }
    for (int idx = c.vcu * 512 + c.tid; idx < 131072; idx += c.G * 512) {
        const int j = idx & 7, ln = (idx >> 3) & 63, st = (idx >> 9) & 7, et = (idx >> 12) & 1, pl = (idx >> 13) & 1, sl = idx >> 14;
        const float w = a.w_router[(size_t)(128 * sl + 16 * st + 8 * (ln >> 5) + j) * 64 + 32 * et + (ln & 31)];
        const unsigned hb = f2bf(w); const unsigned lb = f2bf(w - __builtin_bit_cast(float, hb << 16));
        ((bf16_t*)(ws + WS_WRP))[idx] = (bf16_t)(pl ? lb : hb); }
    for (int mb = gw; mb < T; mb += 4 * NGW) {
        f32x4 v4[4][4]; float mean4[4], rstd4[4];
        const float* const xr4[4] = {a.x + (size_t)mb * D, a.x + (size_t)(mb + NGW) * D, a.x + (size_t)(mb + 2 * NGW) * D, a.x + (size_t)(mb + 3 * NGW) * D};
        ln_rows4<true>(xr4, a.ln_emb_g, a.ln_emb_b, c.lane, v4, mean4, rstd4);
#pragma unroll
        for (int r = 0; r < 4; ++r) { const int m = mb + r * NGW;
            store_row_bf16((bf16_t*)(ws + WS_H0B) + (size_t)m * D, c.lane, v4[r]);
            if (c.lane == 0) { float* st = (float*)(ws + WS_STATS0) + 2 * m; st[0] = mean4[r]; st[1] = rstd4[r]; } }
      for (int r = 0; r < 4; ++r) { const int m = mb + r * NGW;
        { const f32x4 pv = *((const GAS f32x4*)(a.p + (size_t)m * 256) + c.lane); u32x2 w; w.x = pk2(pv.x, pv.y); w.y = pk2(pv.z, pv.w); *((GAS u32x2*)((bf16_t*)(ws + WS_PB) + (size_t)m * 256) + c.lane) = w; }
        if (c.lane < 32) { const double inv = pow(10000.0, -(double)c.lane / 32.0); const double ang = (double)a.positions[m] * inv; double sn, cs; sincos(ang, &sn, &cs);
            ((float*)(ws + WS_CS))[(size_t)m * 32 + c.lane] = (float)cs; ((float*)(ws + WS_CS) + (size_t)T * 32)[(size_t)m * 32 + c.lane] = (float)sn; }
      }
    }
}

struct EpiProj {
    unsigned char* ws; LAS unsigned char* tl;
    __device__ __forceinline__ void operator()(const f32x4 (&acc)[2][2][4][2], const pg8::Unit& u, int wr, int wc, int fr, int fq) const {
        const int pm = u.i0, pn = u.i1;
        const float* cosT = (const float*)(ws + WS_CS); const float* sinT = cosT + (size_t)T * 32;
        const int hh = wc & 1, d1 = 16 * hh + 4 * fq;
        int seg[2]; bool rope[2], isv[2];
#pragma unroll
        for (int bj = 0; bj < 2; ++bj) { seg[bj] = (pn * 256 + 128 * bj + 32 * wc) >> 6; isv[bj] = (seg[bj] >= 16 && seg[bj] < 24) || (seg[bj] >= 49 && seg[bj] < 57); rope[bj] = !isv[bj] && seg[bj] < 57; }
#pragma unroll
        for (int ai = 0; ai < 2; ++ai) {
            f32x4 cs[4], sn[4];
            if (rope[0] || rope[1]) {
#pragma unroll
                for (int m = 0; m < 4; ++m) { const int row = pm * 256 + 128 * ai + 64 * wr + 16 * m + fr; cs[m] = *(const GAS f32x4*)(cosT + (size_t)row * 32 + d1); sn[m] = *(const GAS f32x4*)(sinT + (size_t)row * 32 + d1); }
            }
#pragma unroll
            for (int bj = 0; bj < 2; ++bj) {
                const int sg = seg[bj];
                if (sg >= 58) continue;
                if (sg == 57) {
                    if (hh == 0 && fq < 2) {
#pragma unroll
                        for (int m = 0; m < 4; ++m) { const int row = pm * 256 + 128 * ai + 64 * wr + 16 * m + fr;
                            *(GAS f32x4*)((float*)(ws + WS_IW) + (size_t)row * 8 + d1) = acc[ai][bj][m][0] * WSCALE; }
                    }
                } else if (isv[bj]) {
                    bf16_t* base; int hb;
                    if (sg < 24) { base = (bf16_t*)(ws + WS_AVT); hb = (sg - 16) * 64; }
                    else { base = (bf16_t*)(ws + WS_BVT); hb = ((sg - 49) >> 1) * 128 + ((sg - 49) & 1) * 64; }
                    LAS unsigned char* tb = tl + (wr * 4 + wc) * 1024; const int lane_ = fq * 16 + fr, dvl = lane_ >> 1, half = lane_ & 1;
                    const int dtrue = 16 * hh + 32 * (dvl >> 4) + (dvl & 15); const int pos = swz16(fr);
#pragma unroll
                    for (int m = 0; m < 4; ++m) { const int row0 = pm * 256 + 128 * ai + 64 * wr + 16 * m; const int b = row0 >> 13, s16 = row0 & 8191;
                        const f32x4 x1 = acc[ai][bj][m][0], x2 = acc[ai][bj][m][1];
#pragma unroll
                        for (int i = 0; i < 4; ++i) { *(LAS bf16_t*)(tb + (4 * fq + i) * 32 + pos * 2) = (bf16_t)f2bf(x1[i]); *(LAS bf16_t*)(tb + (16 + 4 * fq + i) * 32 + pos * 2) = (bf16_t)f2bf(x2[i]); }
                        LDS_WAIT(); asm volatile("" ::: "memory");
                        const u32x4 v = *(const LAS u32x4*)(tb + dvl * 32 + half * 16);
                        *(GAS u32x4*)(base + ((size_t)(b * 512 + hb + dtrue)) * S + s16 + half * 8) = v;
                        LDS_WAIT(); asm volatile("" ::: "memory"); }
                } else {
                    bf16_t* base; int stride, col; float sc = 1.f;
                    if (sg < 8) { base = (bf16_t*)(ws + WS_AQ); stride = 512; col = sg * 64; sc = QSCALE; }
                    else if (sg < 16) { base = (bf16_t*)(ws + WS_AK); stride = 512; col = (sg - 8) * 64; }
                    else if (sg < 32) { base = (bf16_t*)(ws + WS_IQ); stride = 512; col = (sg - 24) * 64; }
                    else if (sg == 32) { base = (bf16_t*)(ws + WS_IK); stride = 64; col = 0; }
                    else if (sg < 41) { base = (bf16_t*)(ws + WS_BQ); stride = 512; col = (sg - 33) * 64; sc = QSCALE; }
                    else { base = (bf16_t*)(ws + WS_BK); stride = 512; col = (sg - 41) * 64; }
#pragma unroll
                    for (int m = 0; m < 4; ++m) { const int row = pm * 256 + 128 * ai + 64 * wr + 16 * m + fr;
                        const f32x4 x1 = acc[ai][bj][m][0], x2 = acc[ai][bj][m][1];
                        const f32x4 o1 = (x1 * cs[m] - x2 * sn[m]) * sc, o2 = (x2 * cs[m] + x1 * sn[m]) * sc;
                        bf16_t* p = base + (size_t)row * stride + col + 2 * d1;
                        u32x4 w; w.x = pk2(o1[0], o1[1]); w.y = pk2(o1[2], o1[3]); w.z = pk2(o2[0], o2[1]); w.w = pk2(o2[2], o2[3]);
                        *(GAS u32x4*)p = w; }
                }
            }
            asm volatile("" ::: "memory");
        }
    }
};
struct EpiBf16 {
    bf16_t* out;
    __device__ __forceinline__ void operator()(const f32x4 (&acc)[2][2][4][2], const pg8::Unit& u, int wr, int wc, int fr, int fq) const {
        const int pm = u.i0, pn = u.i1;
#pragma unroll
        for (int ai = 0; ai < 2; ++ai)
#pragma unroll
            for (int m = 0; m < 4; ++m) { const int row = pm * 256 + 128 * ai + 64 * wr + 16 * m + fr;
#pragma unroll
                for (int bj = 0; bj < 2; ++bj) { const f32x4 v0 = acc[ai][bj][m][0], v1 = acc[ai][bj][m][1]; u32x4 w; w.x = pk2(v0[0], v0[1]); w.y = pk2(v0[2], v0[3]); w.z = pk2(v1[0], v1[1]); w.w = pk2(v1[2], v1[3]);
                    *(GAS u32x4*)(out + (size_t)row * D + pn * 256 + 128 * bj + 32 * wc + 8 * fq) = w; } }
    }
};
struct P1TailOrder {
    const char* Bt14; int G, c;
    __device__ __forceinline__ bool next(int i, pg8::Unit& u) const {
        const int L = i * G + c; if (L >= T / 256) return false;
        u.bt = Bt14; u.arow = L * 256; u.i0 = L; u.i1 = 14; u.i2 = 0; return true;
    }
    __device__ __forceinline__ void aoffs(const pg8::Unit& u, const int (&R)[2], const int (&C)[2], int K_, unsigned (&o0)[2], unsigned (&o1)[2]) const {
#pragma unroll
        for (int i = 0; i < 2; ++i) { o0[i] = (unsigned)((u.arow + R[i]) * K_ + C[i]) * 2u; o1[i] = (unsigned)((u.arow + 128 + R[i]) * K_ + C[i]) * 2u; }
    }
};
__device__ __forceinline__ void phase1(const Args& a, const Ctx& c) {
    EpiProj E{a.ws, c.lds + RING_BYTES};
    { pg8::DenseOrder S1; S1.init(a.ws + WS_WIN, T, 14 * 256, D, c.G, (int)blockIdx.x); pg8::gemm_phase(c.lds, (const char*)(a.ws + WS_H0B), D, S1, E); }
    { P1TailOrder S2{(const char*)(a.ws + WS_WIN) + (size_t)14 * 256 * D * 2, c.G, (int)blockIdx.x}; pg8::gemm_phase<EpiProj, P1TailOrder, 0, false, 1>(c.lds, (const char*)(a.ws + WS_H0B), D, S2, E); }
}

constexpr int IX_CAP = 512, IX_NBIN = 520;
constexpr int IXL_CS = 0, IXL_CI = 32768, IXL_MASK = 66560, IXL_Q = 99328, IX_QSTR = 1168, IXL_SM = 136704;
__device__ __forceinline__ void indexer_unit(const Args& a, const Ctx& c, int b, int ch, int half) {
    unsigned char* ws = a.ws; LAS unsigned char* lds = c.lds;
    int tid = c.tid; asm volatile("" : "+v"(tid));
    const int lane = tid & 63, wave = c.wave, r32 = lane & 31, hi = lane >> 5;
    const int ntile = 2 * (ch + 1);
    const int m0 = b * S + ch * 64 + half * 32;
    const bf16_t* IQ = (const bf16_t*)(ws + WS_IQ); const bf16_t* IK = (const bf16_t*)(ws + WS_IK) + (size_t)b * S * 64;
    LAS unsigned* hist = (LAS unsigned*)(lds + IXL_CS);
    LAS float* candS = (LAS float*)(lds + IXL_CS); LAS int* candI = (LAS int*)(lds + IXL_CI);
    LAS unsigned* maskL = (LAS unsigned*)(lds + IXL_MASK);
    LAS float* hiL = (LAS float*)(lds + IXL_SM); LAS float* loL = hiL + 32; LAS int* needL = (LAS int*)(loL + 32); LAS unsigned* ccntL = (LAS unsigned*)(needL + 32);
#pragma unroll
    for (int i = 0; i < 4; ++i) { const int idx = tid + 512 * i, row = idx >> 6, chn = idx & 63;
        *(LAS u32x4*)(lds + IXL_Q + row * IX_QSTR + chn * 16) = *(const GAS u32x4*)(IQ + (size_t)(m0 + row) * 512 + chn * 8); }
    bf16x8 kn[4];
    if (wave < ntile) {
#pragma unroll
        for (int ks = 0; ks < 4; ++ks) kn[ks] = *(const GAS bf16x8*)(IK + (size_t)(wave * 32 + r32) * 64 + 16 * ks + 8 * hi);
    }
    f32x4 wl0, wl1; { const float* wrow = (const float*)(ws + WS_IW) + (size_t)(m0 + (tid >> 4)) * 8; wl0 = *(const GAS f32x4*)wrow; wl1 = *(const GAS f32x4*)(wrow + 4); }
    for (int i = tid; i < 32 * 512; i += 512) hist[i] = 0u;
    if (tid < 32) ccntL[tid] = 0u;
    float wq[8];
    { const f32x4 w0 = *(const GAS f32x4*)((const float*)(ws + WS_IW) + (size_t)(m0 + r32) * 8), w1 = *(const GAS f32x4*)((const float*)(ws + WS_IW) + (size_t)(m0 + r32) * 8 + 4);
      wq[0] = 0.5f * w0[0]; wq[1] = 0.5f * w0[1]; wq[2] = 0.5f * w0[2]; wq[3] = 0.5f * w0[3]; wq[4] = 0.5f * w1[0]; wq[5] = 0.5f * w1[1]; wq[6] = 0.5f * w1[2]; wq[7] = 0.5f * w1[3]; }
    float bt = 0.f;
#pragma unroll
    for (int h = 0; h < 8; ++h) bt += fabsf(wq[h]);
    const float inv = bt > 0.f ? 3.2f / bt : 0.f;
    __syncthreads();
    {
        const int q = tid >> 4, d0 = (tid & 15) * 4; const float wrow[8] = {wl0[0], wl0[1], wl0[2], wl0[3], wl1[0], wl1[1], wl1[2], wl1[3]};
        float acc4[4] = {0.f, 0.f, 0.f, 0.f};
#pragma unroll
        for (int h = 0; h < 8; ++h) { const float wh = 0.5f * wrow[h]; const u32x2 v = *(const LAS u32x2*)(lds + IXL_Q + q * IX_QSTR + h * 128 + d0 * 2);
            acc4[0] += wh * __builtin_bit_cast(float, v.x << 16); acc4[1] += wh * __builtin_bit_cast(float, v.x & 0xffff0000u);
            acc4[2] += wh * __builtin_bit_cast(float, v.y << 16); acc4[3] += wh * __builtin_bit_cast(float, v.y & 0xffff0000u); }
        u32x2 o; o.x = pk2(acc4[0], acc4[1]); o.y = pk2(acc4[2], acc4[3]);
        *(LAS u32x2*)(lds + IXL_Q + q * IX_QSTR + 1024 + d0 * 2) = o;
    }
    __syncthreads();
    const LAS unsigned char* qb = lds + IXL_Q + r32 * IX_QSTR + hi * 16;
    u32x4* scr4 = (u32x4*)(ws + ((int)blockIdx.x < IX_NA ? WS_IXA + (size_t)blockIdx.x * 524288 : WS_IXB + (size_t)((int)blockIdx.x - IX_NA) * 524288)) + lane;
    const float inv16 = inv * 128.f;
#define IX_LDQ(QF, h) do { _Pragma("unroll") for (int ks = 0; ks < 4; ++ks) QF[ks] = *(const LAS bf16x8*)(qb + (h) * 128 + ks * 32); } while (0)
#define IX_HEAD(X, QF) do { X = __builtin_amdgcn_mfma_f32_32x32x16_bf16(kf[0], QF[0], zero16, 0, 0, 0); \
        _Pragma("unroll") for (int ks = 1; ks < 4; ++ks) X = __builtin_amdgcn_mfma_f32_32x32x16_bf16(kf[ks], QF[ks], X, 0, 0, 0); } while (0)
#define IX_ACC(X, h) do { _Pragma("unroll") for (int r = 0; r < 16; ++r) { float t_ = __builtin_fmaf(wq[h], __builtin_fabsf(X[r]), sc[r]); asm volatile("" : "+v"(t_)); sc[r] = t_; } } while (0)
    {
        bf16x8 qreg[8][4], qlin[4];
#pragma unroll
        for (int h = 0; h < 8; ++h) IX_LDQ(qreg[h], h);
        IX_LDQ(qlin, 8);
        bf16x8 kf[4];
        for (int w = wave; w < ntile; w += 8) {
#pragma unroll
            for (int ks = 0; ks < 4; ++ks) kf[ks] = kn[ks];
            if (w + 8 < ntile) {
#pragma unroll
                for (int ks = 0; ks < 4; ++ks) kn[ks] = *(const GAS bf16x8*)(IK + (size_t)((w + 8) * 32 + r32) * 64 + 16 * ks + 8 * hi);
            }
            const f32x16 zero16 = {0.f, 0.f, 0.f, 0.f, 0.f, 0.f, 0.f, 0.f, 0.f, 0.f, 0.f, 0.f, 0.f, 0.f, 0.f, 0.f};
            f32x16 sc, xa, xb;
            IX_HEAD(sc, qlin);
            IX_HEAD(xa, qreg[0]);
#pragma unroll
            for (int h = 0; h < 8; h += 2) {
                __builtin_amdgcn_sched_barrier(0); IX_HEAD(xb, qreg[h + 1]); __builtin_amdgcn_sched_barrier(0);
                IX_ACC(xa, h);
                __builtin_amdgcn_sched_barrier(0); if (h + 2 < 8) { IX_HEAD(xa, qreg[h + 2]); } __builtin_amdgcn_sched_barrier(0);
                IX_ACC(xb, h + 1);
            }
            __builtin_amdgcn_sched_barrier(0); IX_LDQ(qlin, 8);
            unsigned code[16];
#pragma unroll
            for (int r = 0; r < 16; ++r) { int cd = (int)__builtin_fmaf(sc[r], inv16, 32768.5f); cd = cd < 0 ? 0 : cd; cd = cd > 65535 ? 65535 : cd; code[r] = (unsigned)cd;
                lds_add(&hist[r32 * 512 + (cd >> 7)], (cd & 64) ? 65536u : 1u); }
#pragma unroll
            for (int h = 0; h < 2; ++h) scr4[(size_t)(w * 2 + h) * 64] = (u32x4){code[8 * h] | (code[8 * h + 1] << 16), code[8 * h + 2] | (code[8 * h + 3] << 16), code[8 * h + 4] | (code[8 * h + 5] << 16), code[8 * h + 6] | (code[8 * h + 7] << 16)};
        }
    }
#undef IX_HEAD
#undef IX_LDQ
#undef IX_ACC
    __syncthreads();
    LAS unsigned* hiC = (LAS unsigned*)hiL; LAS unsigned* loC = (LAS unsigned*)loL;
    {
        const int q = wave * 4 + (lane >> 4), sub = lane & 15;
        u32x4 hb[8];
#pragma unroll
        for (int i = 0; i < 8; ++i) hb[i] = *(const LAS u32x4*)(hist + q * 512 + 32 * sub + 4 * i);
        int cl = 0;
#pragma unroll
        for (int i = 0; i < 8; ++i)
#pragma unroll
            for (int e = 0; e < 4; ++e) cl += (int)((hb[i][e] & 0xffffu) + (hb[i][e] >> 16));
        int incl = cl;
#pragma unroll
        for (int o = 1; o < 16; o <<= 1) { const int t = __shfl_up(incl, o, 16); if (sub >= o) incl += t; }
        const int total = __shfl(incl, 15, 16);
        const int suf = total - incl;
        if (total < 256) { if (sub == 0) { hiC[q] = 0u; loC[q] = 0u; needL[q] = 0; } }
        else if (suf < 256 && suf + cl >= 256) {
            int run = suf, below = suf, k = 0;
#pragma unroll
            for (int i = 7; i >= 0; --i)
#pragma unroll
                for (int e = 3; e >= 0; --e)
#pragma unroll
                    for (int hf = 1; hf >= 0; --hf) { const int cn = (int)(hf ? hb[i][e] >> 16 : hb[i][e] & 0xffffu);
                        run += cn; const bool lt = run < 256; k += lt ? 1 : 0; below = lt ? run : below; }
            const int bsel = 64 * sub + 63 - k, nd = 256 - below;
            hiC[q] = (unsigned)(bsel + 1) << 6; loC[q] = (unsigned)bsel << 6; needL[q] = nd;
        }
    }
    __syncthreads();
    {
        const unsigned hiT = hiC[r32], loT = loC[r32];
        LAS unsigned* candC = (LAS unsigned*)candS;
        unsigned pk[8], pn_[8];
        if (wave < ntile) {
#pragma unroll
            for (int h = 0; h < 2; ++h) { const u32x4 t_ = scr4[(size_t)(wave * 2 + h) * 64]; pn_[4 * h] = t_[0]; pn_[4 * h + 1] = t_[1]; pn_[4 * h + 2] = t_[2]; pn_[4 * h + 3] = t_[3]; }
        }
        for (int w = wave; w < ntile; w += 8) {
#pragma unroll
            for (int i = 0; i < 8; ++i) pk[i] = pn_[i];
            if (w + 8 < ntile) {
#pragma unroll
                for (int h = 0; h < 2; ++h) { const u32x4 t_ = scr4[(size_t)((w + 8) * 2 + h) * 64]; pn_[4 * h] = t_[0]; pn_[4 * h + 1] = t_[1]; pn_[4 * h + 2] = t_[2]; pn_[4 * h + 3] = t_[3]; }
            }
            unsigned bits = 0u;
#pragma unroll
            for (int r = 0; r < 16; ++r) { const unsigned cd = (r & 1) ? (pk[r >> 1] >> 16) : (pk[r >> 1] & 0xffffu); const int kb = crow(r, hi);
                const bool sel = cd >= hiT;
                bits |= sel ? (1u << kb) : 0u;
                if (cd >= loT && !sel) { const unsigned pos = lds_add(&ccntL[r32], 1u); if (pos < (unsigned)IX_CAP) candC[r32 * IX_CAP + pos] = (cd << 13) | (unsigned)(8191 - (w * 32 + kb)); } }
            bits |= (unsigned)__shfl_xor((int)bits, 32);
            if (lane < 32) maskL[w * 32 + r32] = bits;
        }
    }
    __syncthreads();
    {   const LAS unsigned* keyL = (const LAS unsigned*)candS;
        for (int qi = 0; qi < 4; ++qi) { const int q = wave * 4 + qi;
            const int nc = min((int)ccntL[q], IX_CAP), nd = needL[q];
            if (nc == 0 || nd <= 0) continue;
            unsigned key[8]; bool val[8];
#pragma unroll
            for (int cch = 0; cch < 8; ++cch) { const int p = cch * 64 + lane; val[cch] = p < nc; key[cch] = val[cch] ? keyL[q * IX_CAP + p] : 0u; }
            unsigned thr = 0u;
            if (nc > nd) { thr = loC[q] << 13;
                if (nc <= 64) {
                    for (int bit = 18; bit >= 0; --bit) { const unsigned cand = thr | (1u << bit); const int cnt = __builtin_popcountll(__ballot(key[0] >= cand));
                        if (cnt >= nd) { thr = cand; if (cnt == nd) break; } }
                } else if (nc <= 128) {
                    for (int bit = 18; bit >= 0; --bit) { const unsigned cand = thr | (1u << bit); const int cnt = __builtin_popcountll(__ballot(key[0] >= cand)) + __builtin_popcountll(__ballot(key[1] >= cand));
                        if (cnt >= nd) { thr = cand; if (cnt == nd) break; } }
                } else if (nc <= 256) {
                    for (int bit = 18; bit >= 0; --bit) { const unsigned cand = thr | (1u << bit); int cnt = 0;
#pragma unroll
                        for (int cch = 0; cch < 4; ++cch) cnt += __builtin_popcountll(__ballot(key[cch] >= cand));
                        if (cnt >= nd) { thr = cand; if (cnt == nd) break; } }
                } else {
                    for (int bit = 18; bit >= 0; --bit) { const unsigned cand = thr | (1u << bit); int cnt = 0;
#pragma unroll
                        for (int cch = 0; cch < 8; ++cch) cnt += __builtin_popcountll(__ballot(key[cch] >= cand));
                        if (cnt >= nd) { thr = cand; if (cnt == nd) break; } } } }
#pragma unroll
            for (int cch = 0; cch < 8; ++cch) if (val[cch] && key[cch] >= thr) { const int ki = 8191 - (int)(key[cch] & 8191u);
                __hip_atomic_fetch_or(&maskL[(ki >> 5) * 32 + q], 1u << (ki & 31), __ATOMIC_RELAXED, __HIP_MEMORY_SCOPE_WORKGROUP); }
        }
    }
    __syncthreads();
    unsigned* gm = (unsigned*)(ws + WS_MASK) + ((size_t)b * 16512 + (size_t)ch * (ch + 1)) * 64 + half * 32;
    for (int idx = tid; idx < ntile * 32; idx += 512) gm[(size_t)(idx >> 5) * 64 + (idx & 31)] = maskL[idx];
    __syncthreads();
}
__device__ __forceinline__ void phase2(const Args& a, const Ctx& c) {
    for (int job = c.vcu; job < 512; job += c.G) { const int b = job >> 7, cp = (job >> 1) & 63, half = job & 1;
        indexer_unit(a, c, b, cp, half); indexer_unit(a, c, b, 127 - cp, half); }
}

constexpr int AT_KB = 9216, AT_VOFF = 2 * AT_KB, AT_TR = 73728, AT_TRW = 8704, AT_TSTR = 272;
template <int DV, bool MASKED>
__device__ __forceinline__ void attn_run(const Ctx& c, const bf16_t* Qrow0, const bf16_t* Krow0, const bf16_t* VT, const unsigned* gmask_b, int q0, f32x16 (&o)[DV / 32], float& lsum,
                                         const bf16_t* nK, const bf16_t* nVT, const bool pre, u32x4& kreg2, u32x4 (&vreg2)[DV / 64]) {
    LAS unsigned char* lds = c.lds;
    int tid = c.tid; asm volatile("" : "+v"(tid));
    const int lane = tid & 63, wave = c.wave, r32 = lane & 31, hi = lane >> 5;
    constexpr int NV = DV / 64, VB = DV * 144, NPV = DV / 8;
    const int qw0 = q0 + 32 * wave, cw = qw0 >> 6, NTw = cw + 1, NT = (q0 >> 6) + 4;
    bf16x8 qf[4];
#pragma unroll
    for (int ks = 0; ks < 4; ++ks) qf[ks] = *(const GAS bf16x8*)(Qrow0 + (size_t)(32 * wave + r32) * 512 + 16 * ks + 8 * hi);
#pragma unroll
    for (int i = 0; i < DV / 32; ++i) o[i] = (f32x16){0.f, 0.f, 0.f, 0.f, 0.f, 0.f, 0.f, 0.f, 0.f, 0.f, 0.f, 0.f, 0.f, 0.f, 0.f, 0.f};
    float mref = 0.f, lrun = 0.f;
    f32x16 negm = {0.f, 0.f, 0.f, 0.f, 0.f, 0.f, 0.f, 0.f, 0.f, 0.f, 0.f, 0.f, 0.f, 0.f, 0.f, 0.f};
    u32x4 kreg, vreg[NV];
    const int krow = tid >> 3, kch = tid & 7;
    const LAS unsigned char* kfb = lds + r32 * 144 + hi * 16;
    const LAS unsigned char* vfb = lds + AT_VOFF + r32 * 144 + hi * 16;
#define AT_LOADK(KB, t, KR) do { KR = *(const GAS u32x4*)((KB) + (size_t)((t) * 64 + krow) * 512 + kch * 8); } while (0)
#define AT_LOADV(VB_, t, VR) do { _Pragma("unroll") for (int _i = 0; _i < NV; ++_i) VR[_i] = *(const GAS u32x4*)((VB_) + (size_t)(krow + 64 * _i) * S + (t) * 64 + kch * 8); } while (0)
#define AT_STOREK(bf, KR) do { *(LAS u32x4*)(lds + (bf) * AT_KB + krow * 144 + kch * 16) = KR; } while (0)
#define AT_STOREV(vi, VR) do { _Pragma("unroll") for (int _i = 0; _i < NV; ++_i) *(LAS u32x4*)(lds + AT_VOFF + (vi) * VB + (krow + 64 * _i) * 144 + kch * 16) = VR[_i]; } while (0)
#define AT_KF(bf, g) (*(const LAS bf16x8*)(kfb + (bf) * AT_KB + ((g) & 1) * (32 * 144) + ((g) >> 1) * 32))
#define AT_VF(vi, g) (*(const LAS bf16x8*)(vfb + (vi) * VB + ((g) >> 2) * (32 * 144) + ((g) & 3) * 32))
#define AT_SBAR() __builtin_amdgcn_sched_barrier(0)
#define AT_MAX(X0, X1, mx) do { mx = fmaxf(fmaxf(X0[0], X1[0]), fmaxf(X0[1], X1[1])); \
        _Pragma("unroll") for (int r = 2; r < 16; r += 2) mx = fmaxf(fmaxf(mx, X0[r]), fmaxf(X1[r], fmaxf(X0[r + 1], X1[r + 1]))); \
        mx = xmax32(mx); } while (0)
#define AT_EXP4(X0, X1, g) do { _Pragma("unroll") for (int r = 4 * (g); r < 4 * (g) + 4; ++r) { float p0 = __builtin_amdgcn_exp2f(X0[r]), p1 = __builtin_amdgcn_exp2f(X1[r]); \
            if (MASKED) { const int kbit = (r & 3) + 8 * (r >> 2); int m0_, m1_; asm("v_bfe_i32 %0, %1, %2, 1" : "=v"(m0_) : "v"(w0), "n"(kbit)); asm("v_bfe_i32 %0, %1, %2, 1" : "=v"(m1_) : "v"(w1), "n"(kbit)); \
                p0 = __builtin_bit_cast(float, __builtin_bit_cast(int, p0) & m0_); p1 = __builtin_bit_cast(float, __builtin_bit_cast(int, p1) & m1_); } \
            X0[r] = p0; X1[r] = p1; } } while (0)
    if (!pre) {
        AT_LOADK(Krow0, 0, kreg); AT_STOREK(0, kreg); AT_LOADV(VT, 0, vreg); AT_STOREV(0, vreg); AT_LOADK(Krow0, 1, kreg); AT_STOREK(1, kreg);
        AT_LOADK(Krow0, 2, kreg2); AT_LOADV(VT, 1, vreg2);
        __syncthreads();
    }
    const unsigned* mrow = MASKED ? gmask_b + ((size_t)cw * (cw + 1)) * 64 + (qw0 & 63) + r32 : nullptr;
    unsigned wn0 = 0u, wn1 = 0u;
    if (MASKED) { wn0 = mrow[(size_t)2 * 64]; wn1 = mrow[(size_t)3 * 64]; }
    f32x16 pa0, pa1, pb0, pb1;
    bf16x8 pk[2][2];
    int w0 = -1, w1 = -1;
    {
#pragma unroll
        for (int g = 0; g < 8; ++g) { const bf16x8 kf = AT_KF(0, g);
            if (g & 1) pa1 = __builtin_amdgcn_mfma_f32_32x32x16_bf16(kf, qf[g >> 1], g < 2 ? negm : pa1, 0, 0, 0); else pa0 = __builtin_amdgcn_mfma_f32_32x32x16_bf16(kf, qf[g >> 1], g < 2 ? negm : pa0, 0, 0, 0); }
        float mx; AT_MAX(pa0, pa1, mx); mref = mx;
#pragma unroll
        for (int r = 0; r < 16; ++r) { negm[r] = -mref; pa0[r] -= mref; pa1[r] -= mref; }
        if (MASKED) { w0 = (int)(mrow[0] >> (4 * hi)); w1 = (int)(mrow[64] >> (4 * hi)); }
#pragma unroll
        for (int g = 0; g < 4; ++g) AT_EXP4(pa0, pa1, g);
    }
    __syncthreads();
#define AT_STEP(t, Y0, Y1, X0, X1, KL, VL, KS, VS) do { \
        const int kb_ = (t) & 1, vb_ = ((t) - 1) & 1; \
        if (MASKED) { asm volatile("" : "+v"(wn0), "+v"(wn1)); w0 = (int)(wn0 >> (4 * hi)); w1 = (int)(wn1 >> (4 * hi)); \
            const int tm_ = min((t) + 1, NTw); wn0 = mrow[(size_t)(2 * tm_) * 64]; wn1 = mrow[(size_t)(2 * tm_ + 1) * 64]; }     \
        AT_SBAR(); \
        { const bf16_t* kb2_ = Krow0; int tk_ = (t) + 2; if (tk_ >= NT) { if (nK) { kb2_ = nK; tk_ -= NT; } else tk_ = NT - 1; }     \
          const bf16_t* vb2_ = VT; int tv_ = (t) + 1; if (tv_ >= NT) { if (nVT) { vb2_ = nVT; tv_ -= NT; } else tv_ = NT - 1; } \
          AT_LOADK(kb2_, tk_, KL);                      \
          AT_LOADV(vb2_, tv_, VL); }                    \
        if ((t) <= NTw) {                               \
            float sacc = 0.f, fres = 1.f; \
              \
            bf16x8 kfr[8]; kfr[0] = AT_KF(kb_, 0); kfr[1] = AT_KF(kb_, 1); \
            AT_SBAR(); \
            _Pragma("unroll") for (int g = 0; g < 8; ++g) { if (g + 2 < 8) kfr[g + 2] = AT_KF(kb_, g + 2); const bf16x8 kf = kfr[g]; \
                if (g & 1) X1 = __builtin_amdgcn_mfma_f32_32x32x16_bf16(kf, qf[g >> 1], g < 2 ? negm : X1, 0, 0, 0); else X0 = __builtin_amdgcn_mfma_f32_32x32x16_bf16(kf, qf[g >> 1], g < 2 ? negm : X0, 0, 0, 0); \
                  \
                { float t0_, t1_; asm("v_add_f32 %0, %1, %2" : "=v"(t0_) : "v"(Y0[2 * g]), "v"(Y0[2 * g + 1])); asm("v_add_f32 %0, %1, %2" : "=v"(t1_) : "v"(Y1[2 * g]), "v"(Y1[2 * g + 1])); \
                  asm("v_add_f32 %0, %1, %2" : "=v"(t0_) : "v"(t0_), "v"(t1_)); asm("v_add_f32 %0, %1, %2" : "+v"(sacc) : "v"(sacc), "v"(t0_)); }     \
                { const int s_ = g >> 2, j_ = g & 3; unsigned a_ = pk2(Y0[2 * g], Y0[2 * g + 1]), b_ = pk2(Y1[2 * g], Y1[2 * g + 1]); \
                  u32x4 t0_ = __builtin_bit_cast(u32x4, pk[0][s_]), t1_ = __builtin_bit_cast(u32x4, pk[1][s_]); t0_[j_] = a_; t1_[j_] = b_; pk[0][s_] = __builtin_bit_cast(bf16x8, t0_); pk[1][s_] = __builtin_bit_cast(bf16x8, t1_); } \
                AT_SBAR(); } \
            lrun += sacc; \
              \
            float dl; { const float tot_ = xsum32(sacc);     \
              dl = (tot_ > 65536.f && tot_ < 1.0e30f) ? (float)((int)(__builtin_bit_cast(unsigned, tot_) >> 23) - 127) : 0.f; }     \
            if (__any(dl != 0.f)) { mref += dl; fres = __builtin_amdgcn_exp2f(-dl); lrun *= fres; \
                _Pragma("unroll") for (int r = 0; r < 16; ++r) { X0[r] -= dl; X1[r] -= dl; negm[r] = -mref; } } \
              \
            bf16x8 vfr[NPV]; vfr[0] = AT_VF(vb_, 0); vfr[1] = AT_VF(vb_, 1); \
            AT_SBAR(); \
            _Pragma("unroll") for (int g = 0; g < NPV; ++g) { if (g + 2 < NPV) vfr[g + 2] = AT_VF(vb_, g + 2); \
                o[g >> 2] = __builtin_amdgcn_mfma_f32_32x32x16_bf16(vfr[g], pk[(g >> 1) & 1][g & 1], o[g >> 2], 0, 0, 0); \
                if (NPV == 16) { if (!(g & 3)) AT_EXP4(X0, X1, g >> 2); } else { if (!(g & 1)) AT_EXP4(X0, X1, g >> 1); } \
                AT_SBAR(); } \
            if (__any(fres != 1.f)) { _Pragma("unroll") for (int i = 0; i < DV / 32; ++i) o[i] = o[i] * fres; }     \
        } \
        AT_STOREK(((t) + 1) & 1, KS); \
        AT_STOREV((t) & 1, VS); \
        __syncthreads(); \
    } while (0)
#pragma unroll 1
    for (int t = 1; t <= NT; t += 2) { AT_STEP(t, pa0, pa1, pb0, pb1, kreg, vreg, kreg2, vreg2); AT_STEP(t + 1, pb0, pb1, pa0, pa1, kreg2, vreg2, kreg, vreg); }
#undef AT_STEP
#undef AT_EXP4
#undef AT_MAX
#undef AT_SBAR
#undef AT_KF
#undef AT_VF
#undef AT_LOADK
#undef AT_LOADV
#undef AT_STOREK
#undef AT_STOREV
    lsum = lrun + __shfl_xor(lrun, 32);
}
template <int DV>
__device__ __forceinline__ void attn_store(const Ctx& c, const f32x16 (&v)[DV / 32], bf16_t* dst) {
    LAS unsigned char* tb = c.lds + AT_TR + c.wave * AT_TRW;
    int lane = c.lane; asm volatile("" : "+v"(lane));
    const int r32 = lane & 31, hi = lane >> 5;
#pragma unroll
    for (int i = 0; i < DV / 32; ++i)
#pragma unroll
        for (int g = 0; g < 4; ++g) { u32x2 w; w.x = pk2(v[i][4 * g], v[i][4 * g + 1]); w.y = pk2(v[i][4 * g + 2], v[i][4 * g + 3]);
            *(LAS u32x2*)(tb + r32 * AT_TSTR + (32 * i + 8 * g + 4 * hi) * 2) = w; }
    LDS_WAIT(); asm volatile("" ::: "memory");
    constexpr int CPR = DV / 8;
#pragma unroll
    for (int k = 0; k < DV / 16; ++k) { const int idx = lane + 64 * k, row = idx / CPR, ch = idx % CPR;
        *(GAS u32x4*)(dst + (size_t)row * D + ch * 8) = *(const LAS u32x4*)(tb + row * AT_TSTR + ch * 16); }
    LDS_WAIT(); asm volatile("" ::: "memory");
}
__device__ __forceinline__ void attn_unit_A(const Args& a, const Ctx& c, int b, int head, int qblk, const bool pre, const bool has_next, u32x4& kreg2, u32x4 (&vreg2)[1]) {
    unsigned char* ws = a.ws; const int q0 = qblk * 256;
    f32x16 o[2]; float l;
    const bf16_t* Kb = (const bf16_t*)(ws + WS_AK) + (size_t)b * S * 512 + head * 64; const bf16_t* Vb = (const bf16_t*)(ws + WS_AVT) + (size_t)(b * 8 + head) * 64 * S;
    attn_run<64, true>(c, (const bf16_t*)(ws + WS_AQ) + (size_t)(b * S + q0) * 512 + head * 64, Kb, Vb, (const unsigned*)(ws + WS_MASK) + (size_t)b * 16512 * 64, q0, o, l,
                       has_next ? Kb : nullptr, has_next ? Vb : nullptr, pre, kreg2, vreg2);
    const float il = l > 0.f ? 1.f / l : 0.f;
    o[0] = o[0] * il; o[1] = o[1] * il;
    attn_store<64>(c, o, (bf16_t*)(ws + WS_AO) + (size_t)(b * S + q0 + 32 * c.wave) * D + head * 64);
}
__device__ __forceinline__ void attn_unit_B(const Args& a, const Ctx& c, int b, int head, int qblk, float lam, const bool pre, const bool has_next, u32x4& kreg2, u32x4 (&vreg2)[2]) {
    unsigned char* ws = a.ws; const int q0 = qblk * 256; int lane = c.lane; asm volatile("" : "+v"(lane)); const int hi = lane >> 5;
    float* st = (float*)(ws + WS_STASH) + ((size_t)(blockIdx.x * 8 + c.wave) * 64 + lane) * 64;
    const bf16_t* VT = (const bf16_t*)(ws + WS_BVT) + (size_t)(b * 4 + head) * 128 * S;
    {   f32x16 o1[4]; float l1;
        attn_run<128, false>(c, (const bf16_t*)(ws + WS_BQ) + (size_t)(b * S + q0) * 512 + (2 * head) * 64, (const bf16_t*)(ws + WS_BK) + (size_t)b * S * 512 + (2 * head) * 64, VT, nullptr, q0, o1, l1,
                             (const bf16_t*)(ws + WS_BK) + (size_t)b * S * 512 + (2 * head + 1) * 64, VT, pre, kreg2, vreg2);
        const float il = l1 > 0.f ? 1.f / l1 : 0.f;
#pragma unroll
        for (int i = 0; i < 4; ++i)
#pragma unroll
            for (int g = 0; g < 4; ++g) *(GAS f32x4*)(st + i * 16 + 4 * g) = (f32x4){o1[i][4 * g], o1[i][4 * g + 1], o1[i][4 * g + 2], o1[i][4 * g + 3]} * il;
    }
    f32x16 o2[4]; float l2;
    attn_run<128, false>(c, (const bf16_t*)(ws + WS_BQ) + (size_t)(b * S + q0) * 512 + (2 * head + 1) * 64, (const bf16_t*)(ws + WS_BK) + (size_t)b * S * 512 + (2 * head + 1) * 64, VT, nullptr, q0, o2, l2,
                         has_next ? (const bf16_t*)(ws + WS_BK) + (size_t)b * S * 512 + (2 * head) * 64 : nullptr, has_next ? VT : nullptr, true, kreg2, vreg2);
    const float il2 = l2 > 0.f ? lam / l2 : 0.f; float ss = 0.f;
#pragma unroll
    for (int i = 0; i < 4; ++i)
#pragma unroll
        for (int g = 0; g < 4; ++g) { const f32x4 sv = *(const GAS f32x4*)(st + i * 16 + 4 * g);
#pragma unroll
            for (int j = 0; j < 4; ++j) { const float d = sv[j] - o2[i][4 * g + j] * il2; o2[i][4 * g + j] = d; ss += d * d; } }
    ss += __shfl_xor(ss, 32);
    const float rr = (1.f / sqrtf(ss * (1.f / 128.f) + RMS_EPS)) * (1.f - LAMBDA_INIT);
#pragma unroll
    for (int i = 0; i < 4; ++i)
#pragma unroll
        for (int g = 0; g < 4; ++g) { const f32x4 gg = *(const GAS f32x4*)(a.subln_g + 32 * i + 8 * g + 4 * hi);
#pragma unroll
            for (int j = 0; j < 4; ++j) o2[i][4 * g + j] = o2[i][4 * g + j] * rr * gg[j]; }
    attn_store<128>(c, o2, (bf16_t*)(ws + WS_AO) + (size_t)(b * S + q0 + 32 * c.wave) * D + 512 + head * 128);
}
__device__ __forceinline__ void phase3(const Args& a, const Ctx& c) {
    float lam;
    { const float p1 = a.lq1[c.lane] * a.lk1[c.lane], p2 = a.lq2[c.lane] * a.lk2[c.lane]; lam = expf(wave_sum(p1)) - expf(wave_sum(p2)) + LAMBDA_INIT; }
    for (int job = c.vcu; job < 768; job += c.G) {
        if (job < 256) { const int b = job >> 6, head = (job >> 4) & 3, j = job & 15; u32x4 k2; u32x4 v2[2]; attn_unit_B(a, c, b, head, j, lam, false, true, k2, v2); attn_unit_B(a, c, b, head, 31 - j, lam, true, false, k2, v2); }
        else { const int p = job - 256, b = p >> 7, head = (p >> 4) & 7, j = p & 15; u32x4 k2; u32x4 v2[1]; attn_unit_A(a, c, b, head, j, false, true, k2, v2); attn_unit_A(a, c, b, head, 31 - j, true, false, k2, v2); }
    }
}

struct EpiY1 {
    const float* x; const float* st; const float* g; const float* bb; float* y1; f32x2* yst;
    __device__ __forceinline__ void operator()(const f32x4 (&acc)[2][2][4][2], const pg8::Unit& u, int wr, int wc, int fr, int fq) const {
        const int pm = u.i0, pn = u.i1; const int col0 = pn * 256 + 32 * wc + 4 * fq;
        f32x4 gv[2][2], bv[2][2];
#pragma unroll
        for (int bj = 0; bj < 2; ++bj)
#pragma unroll
            for (int n = 0; n < 2; ++n) { gv[bj][n] = *(const GAS f32x4*)(g + col0 + 128 * bj + 16 * n); bv[bj][n] = *(const GAS f32x4*)(bb + col0 + 128 * bj + 16 * n); }
#pragma unroll
        for (int ai = 0; ai < 2; ++ai)
#pragma unroll
            for (int m = 0; m < 4; ++m) { const int row = pm * 256 + 128 * ai + 64 * wr + 16 * m + fr;
                const f32x2 ms = *(const GAS f32x2*)(st + 2 * row);
                f32x4 xv[2][2];
#pragma unroll
                for (int bj = 0; bj < 2; ++bj)
#pragma unroll
                    for (int n = 0; n < 2; ++n) xv[bj][n] = *(const GAS f32x4*)(x + (size_t)row * D + col0 + 128 * bj + 16 * n);
                f32x4 s4 = {0.f, 0.f, 0.f, 0.f}, q4 = {0.f, 0.f, 0.f, 0.f};
#pragma unroll
                for (int bj = 0; bj < 2; ++bj)
#pragma unroll
                    for (int n = 0; n < 2; ++n) { const f32x4 yv = ((xv[bj][n] - ms.x) * ms.y * gv[bj][n] + bv[bj][n]) * ALPHA + acc[ai][bj][m][n]; s4 += yv; q4 += yv * yv;
                        *(GAS f32x4*)(y1 + (size_t)row * D + col0 + 128 * bj + 16 * n) = yv; }
                float sv = (s4.x + s4.y) + (s4.z + s4.w), qv = (q4.x + q4.y) + (q4.z + q4.w);
                sv = xsum32(xsum16(sv)); qv = xsum32(xsum16(qv));
                if (fq == 0) yst[(size_t)row * 16 + pn * 4 + wc] = (f32x2){sv, qv}; }
    }
};
__device__ __forceinline__ void phase4(const Args& a, const Ctx& c) {
    pg8::DenseOrder S1; S1.init(a.ws + WS_WO, T, D, D, c.G, (int)blockIdx.x);
    EpiY1 E{a.x, (const float*)(a.ws + WS_STATS0), a.ln_emb_g, a.ln_emb_b, (float*)(a.ws + WS_Y1), (f32x2*)(a.ws + WS_YST)};
    pg8::gemm_phase(c.lds, (const char*)(a.ws + WS_AO), D, S1, E);
    { pg8::DenseOrder S2; S2.init(a.ws + WS_WPP, T, D, 256, c.G, (int)blockIdx.x); EpiBf16 E2{(bf16_t*)(a.ws + WS_PP)};
      pg8::gemm_phase<EpiBf16, pg8::DenseOrder, 1>(c.lds, (const char*)(a.ws + WS_PB), 256, S2, E2); }
}

constexpr int P5_HPB = 272;
constexpr int P5_LO = 128 * P5_HPB, P5_W = 2 * P5_LO, P5_STATS = P5_W + 32768, P5_CNT = P5_STATS + 1024;
__device__ __forceinline__ void phase5(const Args& a, const Ctx& c) {
    unsigned char* ws = a.ws; LAS unsigned char* lds = c.lds; const int tid = c.tid, lane = c.lane, wave = c.wave;
    LAS float* wL = (LAS float*)(lds + P5_W); LAS float* statsL = (LAS float*)(lds + P5_STATS); LAS float* logitL = (LAS float*)lds; LAS unsigned* cntL = (LAS unsigned*)(lds + P5_CNT);
    const float* y1 = (const float*)(ws + WS_Y1);
    for (int tb = c.vcu; tb < 256; tb += c.G) {
        const int m0 = tb * 128;
        const float* yw = y1 + (size_t)(m0 + wave * 16) * D + 2 * lane;
        const float* wsrc = (const float*)(ws + WS_WRP) + 4 * tid;
        f32x2 yv[16]; f32x4 wq[4];
#pragma unroll
        for (int r = 0; r < 16; ++r) yv[r] = *(const GAS f32x2*)(yw + (size_t)r * D);
#pragma unroll
        for (int q = 0; q < 4; ++q) wq[q] = *(const GAS f32x4*)(wsrc + 2048 * q);
        if (lane < 16) {
            const int row = wave * 16 + lane; const f32x4* pp = (const f32x4*)((const f32x2*)(ws + WS_YST) + (size_t)(m0 + row) * 16);
            float sm = 0.f, sq = 0.f;
#pragma unroll
            for (int i = 0; i < 8; ++i) { const f32x4 v = pp[i]; sm += v.x; sq += v.y; sm += v.z; sq += v.w; }
            const float mean = sm * (1.f / D), var = fmaxf(sq * (1.f / D) - mean * mean, 0.f);
            statsL[2 * row] = mean; statsL[2 * row + 1] = 1.f / sqrtf(var + LN_EPS); }
        if (tid < 64) cntL[tid] = 0u;
        __syncthreads();
        const int tg = wave >> 1, et = wave & 1, r32 = lane & 31, hi = lane >> 5;
        f32x16 acc = {0.f, 0.f, 0.f, 0.f, 0.f, 0.f, 0.f, 0.f, 0.f, 0.f, 0.f, 0.f, 0.f, 0.f, 0.f, 0.f};
        bf16_t* hw = (bf16_t*)(ws + WS_H1B) + (size_t)(m0 + wave * 16) * D + 2 * lane;
        const LAS unsigned char* aL = lds + (32 * tg + r32) * P5_HPB + 16 * hi;
        const LAS unsigned char* bL = lds + P5_W + (et * 8) * 1024 + lane * 16;
        float mean16[16], rstd16[16];
#pragma unroll
        for (int r = 0; r < 16; ++r) { mean16[r] = statsL[2 * (wave * 16 + r)]; rstd16[r] = statsL[2 * (wave * 16 + r) + 1]; }
#pragma unroll 1
        for (int sl = 0; sl < 8; ++sl) {
            const f32x2 gv = *(const GAS f32x2*)(a.ln1_g + 128 * sl + 2 * lane), bv = *(const GAS f32x2*)(a.ln1_b + 128 * sl + 2 * lane);
#pragma unroll
            for (int r = 0; r < 16; ++r) { const f32x2 h = (yv[r] - mean16[r]) * rstd16[r] * gv + bv;
                const unsigned hb = pk2(h.x, h.y);
                const unsigned lb = pk2(h.x - __builtin_bit_cast(float, hb << 16), h.y - __builtin_bit_cast(float, hb & 0xffff0000u));
                *(LAS unsigned*)(lds + (wave * 16 + r) * P5_HPB + 4 * lane) = hb; *(LAS unsigned*)(lds + P5_LO + (wave * 16 + r) * P5_HPB + 4 * lane) = lb;
                *(GAS unsigned*)(hw + (size_t)r * D + 128 * sl) = hb; }
#pragma unroll
            for (int q = 0; q < 4; ++q) *(LAS f32x4*)(wL + 4 * tid + 2048 * q) = wq[q];
            if (sl < 7) {
#pragma unroll
                for (int r = 0; r < 16; ++r) yv[r] = *(const GAS f32x2*)(yw + (size_t)r * D + 128 * (sl + 1));
#pragma unroll
                for (int q = 0; q < 4; ++q) wq[q] = *(const GAS f32x4*)(wsrc + 8192 * (sl + 1) + 2048 * q); }
            __syncthreads();
            bf16x8 fa[2][2][2], fb[2][2][2];
#pragma unroll
            for (int q = 0; q < 2; ++q) { fa[0][q][0] = *(const LAS bf16x8*)(aL + 32 * q); fa[0][q][1] = *(const LAS bf16x8*)(aL + P5_LO + 32 * q);
                fb[0][q][0] = *(const LAS bf16x8*)(bL + 1024 * q); fb[0][q][1] = *(const LAS bf16x8*)(bL + 16384 + 1024 * q); }
#pragma unroll
            for (int bt = 0; bt < 4; ++bt) {
                if (bt < 3) {
#pragma unroll
                    for (int q = 0; q < 2; ++q) { const int st = 2 * (bt + 1) + q;
                        fa[(bt + 1) & 1][q][0] = *(const LAS bf16x8*)(aL + 32 * st); fa[(bt + 1) & 1][q][1] = *(const LAS bf16x8*)(aL + P5_LO + 32 * st);
                        fb[(bt + 1) & 1][q][0] = *(const LAS bf16x8*)(bL + 1024 * st); fb[(bt + 1) & 1][q][1] = *(const LAS bf16x8*)(bL + 16384 + 1024 * st); } }
#pragma unroll
                for (int q = 0; q < 2; ++q) {
                    acc = __builtin_amdgcn_mfma_f32_32x32x16_bf16(fa[bt & 1][q][0], fb[bt & 1][q][0], acc, 0, 0, 0);
                    acc = __builtin_amdgcn_mfma_f32_32x32x16_bf16(fa[bt & 1][q][0], fb[bt & 1][q][1], acc, 0, 0, 0);
                    acc = __builtin_amdgcn_mfma_f32_32x32x16_bf16(fa[bt & 1][q][1], fb[bt & 1][q][0], acc, 0, 0, 0); }
                __builtin_amdgcn_sched_barrier(0);
            }
            __syncthreads();
        }
#pragma unroll
        for (int r = 0; r < 16; ++r) logitL[(32 * tg + crow(r, hi)) * 65 + 32 * et + r32] = acc[r];
        __syncthreads();
        if (wave < 2) {
            const int tok = wave * 64 + lane, m = m0 + tok;
            LAS float* row = logitL + tok * 65; LAS float* srow = logitL + 128 * 65 + tok * 65;
#pragma unroll 8
            for (int e = 0; e < 64; ++e) { const float sg = __builtin_amdgcn_rcpf(1.f + __expf(-row[e])); srow[e] = sg; row[e] = sg + a.router_bias[e]; }
            float gs[8];
#pragma unroll
            for (int g = 0; g < 8; ++g) { float v[8];
#pragma unroll
                for (int j = 0; j < 8; ++j) v[j] = row[8 * g + j];
                const float m1 = fmaxf(fmaxf(fmaxf(v[0], v[1]), fmaxf(v[2], v[3])), fmaxf(fmaxf(v[4], v[5]), fmaxf(v[6], v[7])));
                float m2 = -INFINITY; bool seen = false;
#pragma unroll
                for (int j = 0; j < 8; ++j) { const bool is = (v[j] == m1) && !seen; seen = seen || is; m2 = is ? m2 : fmaxf(m2, v[j]); }
                gs[g] = m1 + m2; }
#pragma unroll
            for (int g = 0; g < 8; ++g) { int rk = 0;
#pragma unroll
                for (int g2 = 0; g2 < 8; ++g2) rk += (gs[g2] > gs[g] || (gs[g2] == gs[g] && g2 < g)) ? 1 : 0;
                if (rk >= 4) {
#pragma unroll
                    for (int j = 0; j < 8; ++j) row[8 * g + j] = -INFINITY; } }
            int sel[8]; float sv[8]; float ssum = 0.f;
#pragma unroll
            for (int k = 0; k < 8; ++k) { float best = -INFINITY; int bi = 0;
#pragma unroll 8
                for (int e = 0; e < 64; ++e) { const float v = row[e]; if (v > best) { best = v; bi = e; } }
                sel[k] = bi; sv[k] = srow[bi]; ssum += sv[k]; row[bi] = -INFINITY; }
            typedef int i32x4 __attribute__((ext_vector_type(4)));
            *(GAS i32x4*)((int*)(ws + WS_EIDX) + (size_t)m * 8) = (i32x4){sel[0], sel[1], sel[2], sel[3]}; *(GAS i32x4*)((int*)(ws + WS_EIDX) + (size_t)m * 8 + 4) = (i32x4){sel[4], sel[5], sel[6], sel[7]};
            f32x4 g0, g1;
#pragma unroll
            for (int k = 0; k < 4; ++k) { g0[k] = sv[k] / ssum * 2.5f; g1[k] = sv[4 + k] / ssum * 2.5f; }
            *(GAS f32x4*)((float*)(ws + WS_GATE) + (size_t)m * 8) = g0; *(GAS f32x4*)((float*)(ws + WS_GATE) + (size_t)m * 8 + 4) = g1;
#pragma unroll
            for (int k = 0; k < 8; ++k) lds_add(&cntL[sel[k]], 1u);
        }
        __syncthreads();
        if (tid < 64) ((unsigned*)(ws + WS_CNTWG))[tb * 64 + tid] = cntL[tid];
        __syncthreads();
    }
}

__device__ __forceinline__ void phase6(const Args& a, const Ctx& c) {
    unsigned char* ws = a.ws; const int tid = c.tid, lane = c.lane;
    LAS unsigned* baseL = (LAS unsigned*)c.lds;
    const unsigned* cntwg = (const unsigned*)(ws + WS_CNTWG);
    for (int tb = c.vcu; tb < 256; tb += c.G) {
        const int r = tb / TBR;
        int* tab = (int*)(ws + WS_TABLES) + r * 240;
        int* tokbuf = (int*)(ws + WS_TOKBUF) + (size_t)r * (RROWS + 256); float* gwbuf = (float*)(ws + WS_GWBUF) + (size_t)r * (RROWS + 256);
        {
            const int e = tid & 63, part = tid >> 6; int tot = 0, pre = 0; unsigned cv[TBR / 8];
#pragma unroll
            for (int j = 0; j < TBR / 8; ++j) cv[j] = cntwg[(r * TBR + part * (TBR / 8) + j) * 64 + e];
#pragma unroll
            for (int j = 0; j < TBR / 8; ++j) { tot += (int)cv[j]; if (r * TBR + part * (TBR / 8) + j < tb) pre += (int)cv[j]; }
            baseL[64 + tid] = (unsigned)tot; baseL[64 + 512 + tid] = (unsigned)pre;
        }
        int ea[2]; float ga[2];
#pragma unroll
        for (int j = 0; j < 2; ++j) { const int ai = tid + 512 * j, tok = tb * 128 + (ai >> 3), k = ai & 7; ea[j] = ((const int*)(ws + WS_EIDX))[(size_t)tok * 8 + k]; ga[j] = ((const float*)(ws + WS_GATE))[(size_t)tok * 8 + k]; }
        __syncthreads();
        if (tid < 64) { const int e = tid; int tot = 0, pre = 0;
#pragma unroll
            for (int p8 = 0; p8 < 8; ++p8) { tot += (int)baseL[64 + 64 * p8 + e]; pre += (int)baseL[64 + 512 + 64 * p8 + e]; }
            int incl = tot, nt = (tot + 255) >> 8, incl2 = nt;
#pragma unroll
            for (int o = 1; o < 64; o <<= 1) { const int t1 = __shfl_up(incl, o), t2 = __shfl_up(incl2, o); if (lane >= o) { incl += t1; incl2 += t2; } }
            baseL[e] = (unsigned)(incl - tot + pre);
            if ((tb % TBR) == 0) { tab[e] = tot; tab[80 + e] = incl - tot; tab[160 + e] = incl2 - nt;
                if (e == 63) { tab[64] = RT; tab[80 + 64] = RROUTED; tab[160 + 64] = incl2; tab[160 + 65] = incl2 + RT / 256; }
                int* ut = (int*)(ws + WS_UTAB) + r * 640;
                for (int j = 0; j < nt; ++j) ut[incl2 - nt + j] = e | (j << 8);
                if (e == 63) { for (int j = 0; j < RT / 256; ++j) ut[incl2 + j] = 64 | (j << 8); } }
        }
        __syncthreads();
#pragma unroll
        for (int j = 0; j < 2; ++j) { const int ai = tid + 512 * j, tok = tb * 128 + (ai >> 3), k = ai & 7;
            const unsigned slot = lds_add(&baseL[ea[j]], 1u);
            tokbuf[slot] = tok; gwbuf[slot] = ga[j]; ((int*)(ws + WS_SLOTOF))[(size_t)tok * 8 + k] = (int)slot; }
        if (tid < 128) { const int tok = tb * 128 + tid; const int slot = RROUTED + (tok % RT); tokbuf[slot] = tok; gwbuf[slot] = 1.f; }
        if ((tb % TBR) == 0 && tid < 256) { tokbuf[RROWS + tid] = 0; gwbuf[RROWS + tid] = 0.f; }
        __syncthreads();
    }
}

template <bool UT>
struct GroupOrderT {
    const LAS int* tab; const char* Wbase; size_t wstride; int NPN, G, c, K; const int* tok;
    __device__ __forceinline__ bool next(int i, pg8::Unit& u) const {
        const int L = i * G + c; if (L >= tab[160 + 65] * NPN) return false;
        const int tau = L / NPN, pn = L % NPN; int e, j;
        if constexpr (UT) { const int info = tab[256 + tau]; e = info & 255; j = info >> 8; }
        else { int lo = 0, hi = 64;
            while (lo < hi) { const int mid = (lo + hi + 1) >> 1; if (tab[160 + mid] <= tau) lo = mid; else hi = mid - 1; }
            e = lo; j = tau - tab[160 + e]; }
        u.bt = Wbase + (size_t)e * wstride + (size_t)pn * 256 * K * 2; u.arow = tab[80 + e] + 256 * j; u.i0 = e; u.i1 = pn; const int rem = tab[e] - 256 * j; u.i2 = rem < 256 ? rem : 256; return true;
    }
    __device__ __forceinline__ void aoffs(const pg8::Unit& u, const int (&R)[2], const int (&C)[2], int K_, unsigned (&o0)[2], unsigned (&o1)[2]) const {
#pragma unroll
        for (int i = 0; i < 2; ++i) { int r0 = u.arow + R[i], r1 = r0 + 128; if (tok) { r0 = tok[r0]; r1 = tok[r1]; }
            o0[i] = (unsigned)(r0 * K_ + C[i]) * 2u; o1[i] = (unsigned)(r1 * K_ + C[i]) * 2u; }
    }
};
struct EpiHid {
    bf16_t* hid;
    __device__ __forceinline__ void operator()(const f32x4 (&acc)[2][2][4][2], const pg8::Unit& u, int wr, int wc, int fr, int fq) const {
        const int pn = u.i1, lim = u.i2;
#pragma unroll
        for (int ai = 0; ai < 2; ++ai)
#pragma unroll
            for (int m = 0; m < 4; ++m) { const int row = 128 * ai + 64 * wr + 16 * m + fr;
                if (row < lim) {
#pragma unroll
                    for (int bj = 0; bj < 2; ++bj) { const f32x4 g = acc[ai][bj][m][0], uu = acc[ai][bj][m][1]; f32x4 h;
#pragma unroll
                        for (int i = 0; i < 4; ++i) h[i] = g[i] * __builtin_amdgcn_rcpf(1.f + __expf(-g[i])) * uu[i];
                        u32x2 w; w.x = pk2(h[0], h[1]); w.y = pk2(h[2], h[3]);
                        *(GAS u32x2*)(hid + (size_t)(u.arow + row) * 256 + 128 * pn + 64 * bj + 16 * wc + 4 * fq) = w; } } }
    }
};
struct EpiSlot {
    unsigned char* slots; unsigned char* slots_sh; const float* rowf;
    __device__ __forceinline__ void operator()(const f32x4 (&acc)[2][2][4][2], const pg8::Unit& u, int wr, int wc, int fr, int fq, const LAS float* gwl) const {
        const int pn = u.i1, lim = u.i2; unsigned char* const sb = u.i0 == NE ? slots_sh : slots;
        float wgt[2][4];
#pragma unroll
        for (int ai = 0; ai < 2; ++ai)
#pragma unroll
            for (int m = 0; m < 4; ++m) wgt[ai][m] = gwl[128 * ai + 64 * wr + 16 * m + fr];
#pragma unroll
        for (int ai = 0; ai < 2; ++ai)
#pragma unroll
            for (int m = 0; m < 4; ++m) { const int row = 128 * ai + 64 * wr + 16 * m + fr;
                if (row < lim) { u32x4 w;
#pragma unroll
                    for (int bj = 0; bj < 2; ++bj) { f32x4 v0 = acc[ai][bj][m][0] * wgt[ai][m], v1 = acc[ai][bj][m][1] * wgt[ai][m];
#pragma unroll
                        for (int i = 0; i < 4; ++i) { v0[i] = __builtin_amdgcn_fmed3f(v0[i], -448.f, 448.f); v1[i] = __builtin_amdgcn_fmed3f(v1[i], -448.f, 448.f); }
                        int t_ = __builtin_amdgcn_cvt_pk_fp8_f32(v0[0], v0[1], 0, false); w[2 * bj] = (unsigned)__builtin_amdgcn_cvt_pk_fp8_f32(v0[2], v0[3], t_, true);
                        t_ = __builtin_amdgcn_cvt_pk_fp8_f32(v1[0], v1[1], 0, false); w[2 * bj + 1] = (unsigned)__builtin_amdgcn_cvt_pk_fp8_f32(v1[2], v1[3], t_, true); }
                    *(GAS u32x4*)(sb + (size_t)(u.arow + row) * D + pn * 256 + 64 * wc + 16 * fq) = w; } }
    }
};
__device__ __forceinline__ void load_tab(const Args& a, const Ctx& c, int r) {
    LAS int* tabL = (LAS int*)(c.lds + MISC_OFF + 256);
    __syncthreads();
    { int t_ = c.tid; asm volatile("" : "+v"(t_));
      const int* tg = (const int*)(a.ws + WS_TABLES) + r * 240; const int* ug = (const int*)(a.ws + WS_UTAB) + r * 640;
      const int v0 = tg[min(t_, 239)], v1 = ug[t_], v2 = ug[512 + min(t_, 127)];
      if (t_ < 240) tabL[t_] = v0;
      tabL[256 + t_] = v1;
      if (t_ < 128) tabL[768 + t_] = v2; }
    __syncthreads();
}
__device__ __forceinline__ void phase7(const Args& a, const Ctx& c, int r) {
    load_tab(a, c, r);
    GroupOrderT<true> S1{(const LAS int*)(c.lds + MISC_OFF + 256), (const char*)(a.ws + WS_WGU), (size_t)512 * D * 2, 2, c.G, c.vcu, D, (const int*)(a.ws + WS_TOKBUF) + (size_t)r * (RROWS + 256)};
    EpiHid E{(bf16_t*)((unsigned char*)a.out + OUT_HID)};
    pg8::gemm_phase(c.lds, (const char*)(a.ws + WS_H1B), D, S1, E);
}
__device__ __forceinline__ void phase8(const Args& a, const Ctx& c, int r) {
    load_tab(a, c, r);
    GroupOrderT<true> S1{(const LAS int*)(c.lds + MISC_OFF + 256), (const char*)(a.ws + WS_WD), (size_t)D * 256 * 2, 4, c.G, c.vcu, 256, nullptr};
    EpiSlot E{a.ws + WS_SLOTS, (unsigned char*)a.out + OUT_SLOTS_SH - (size_t)RROUTED * D, (const float*)(a.ws + WS_GWBUF) + (size_t)r * (RROWS + 256)};
    pg8::gemm_phase<EpiSlot, GroupOrderT<true>, 2, true>(c.lds, (const char*)a.out + OUT_HID, 256, S1, E);
}
__device__ __forceinline__ void phase9(const Args& a, const Ctx& c, int r) {
    unsigned char* ws = a.ws; const int lane = c.lane; const int gw = c.vcu * 8 + c.wave, NGW = c.G * 8;
    const unsigned char* slots = ws + WS_SLOTS;
    const unsigned char* slots_sh = (const unsigned char*)a.out + OUT_SLOTS_SH;
    for (int mi = gw; mi < RT; mi += NGW) { const int m = r * RT + mi;
        int sl[9];
        { const int* so = (const int*)(ws + WS_SLOTOF) + (size_t)m * 8;
#pragma unroll
          for (int k = 0; k < 8; ++k) sl[k] = so[k];
          sl[8] = mi; }
        float v[16];
        bf16_t* hrow = (bf16_t*)(ws + WS_H1B) + (size_t)m * D + 16 * lane;
        { const u32x4 h0 = *(const GAS u32x4*)hrow, h1 = *(const GAS u32x4*)(hrow + 8);
#pragma unroll
          for (int i = 0; i < 4; ++i) { v[2 * i] = ALPHA * __builtin_bit_cast(float, h0[i] << 16); v[2 * i + 1] = ALPHA * __builtin_bit_cast(float, h0[i] & 0xffff0000u);
              v[8 + 2 * i] = ALPHA * __builtin_bit_cast(float, h1[i] << 16); v[8 + 2 * i + 1] = ALPHA * __builtin_bit_cast(float, h1[i] & 0xffff0000u); } }
        u32x4 sw[9];
#pragma unroll
        for (int k = 0; k < 9; ++k) sw[k] = *(const GAS u32x4*)((k == 8 ? slots_sh : slots) + (size_t)sl[k] * D + 16 * lane);
#pragma unroll
        for (int k = 0; k < 9; ++k)
#pragma unroll
            for (int i = 0; i < 4; ++i) { const f32x2 lo = __builtin_amdgcn_cvt_pk_f32_fp8((int)sw[k][i], false), hi = __builtin_amdgcn_cvt_pk_f32_fp8((int)sw[k][i], true);
                v[4 * i] += lo.x; v[4 * i + 1] += lo.y; v[4 * i + 2] += hi.x; v[4 * i + 3] += hi.y; }
        float s = 0.f;
#pragma unroll
        for (int i = 0; i < 16; i += 4) s += (v[i] + v[i + 1]) + (v[i + 2] + v[i + 3]);
        const float mean = wave_sum(s) * (1.f / D); float s2 = 0.f;
#pragma unroll
        for (int i = 0; i < 16; ++i) { const float d = v[i] - mean; s2 += d * d; }
        const float rstd = 1.f / sqrtf(wave_sum(s2) * (1.f / D) + LN_EPS);
        u32x4 o0, o1;
#pragma unroll
        for (int q = 0; q < 4; ++q) { const f32x4 gg = *((const GAS f32x4*)(a.ln2_g + 16 * lane) + q), b4 = *((const GAS f32x4*)(a.ln2_b + 16 * lane) + q);
            const float y0 = (v[4 * q] - mean) * rstd * gg.x + b4.x, y1 = (v[4 * q + 1] - mean) * rstd * gg.y + b4.y, y2 = (v[4 * q + 2] - mean) * rstd * gg.z + b4.z, y3 = (v[4 * q + 3] - mean) * rstd * gg.w + b4.w;
            if (q < 2) { o0[2 * q] = pk2(y0, y1); o0[2 * q + 1] = pk2(y2, y3); } else { o1[2 * (q - 2)] = pk2(y0, y1); o1[2 * (q - 2) + 1] = pk2(y2, y3); } }
        *(GAS u32x4*)hrow = o0; *(GAS u32x4*)(hrow + 8) = o1;
    }
}
struct EpiFinal {
    const bf16_t* h2b; const bf16_t* pp; const float* bias; float* out;
    __device__ __forceinline__ void operator()(const f32x4 (&acc)[2][2][4][2], const pg8::Unit& u, int wr, int wc, int fr, int fq) const {
        const int pm = u.i0, pn = u.i1; const int col0 = pn * 256 + 32 * wc + 4 * fq;
        f32x4 bv[2][2];
#pragma unroll
        for (int bj = 0; bj < 2; ++bj)
#pragma unroll
            for (int n = 0; n < 2; ++n) bv[bj][n] = *(const GAS f32x4*)(bias + col0 + 128 * bj + 16 * n);
#pragma unroll
        for (int ai = 0; ai < 2; ++ai)
#pragma unroll
            for (int m = 0; m < 4; ++m) { const size_t rowoff = (size_t)(pm * 256 + 128 * ai + 64 * wr + 16 * m + fr) * D + col0;
                u32x2 pw[2][2], hw[2][2];
#pragma unroll
                for (int bj = 0; bj < 2; ++bj)
#pragma unroll
                    for (int n = 0; n < 2; ++n) { pw[bj][n] = *(const GAS u32x2*)(pp + rowoff + 128 * bj + 16 * n); hw[bj][n] = *(const GAS u32x2*)(h2b + rowoff + 128 * bj + 16 * n); }
#pragma unroll
                for (int bj = 0; bj < 2; ++bj)
#pragma unroll
                    for (int n = 0; n < 2; ++n) { const f32x4 z = acc[ai][bj][m][n] + bv[bj][n]; const u32x2 p_ = pw[bj][n], h_ = hw[bj][n];
                        const float pf[4] = {__builtin_bit_cast(float, p_.x << 16), __builtin_bit_cast(float, p_.x & 0xffff0000u), __builtin_bit_cast(float, p_.y << 16), __builtin_bit_cast(float, p_.y & 0xffff0000u)};
                        const float hf[4] = {__builtin_bit_cast(float, h_.x << 16), __builtin_bit_cast(float, h_.x & 0xffff0000u), __builtin_bit_cast(float, h_.y << 16), __builtin_bit_cast(float, h_.y & 0xffff0000u)};
                        f32x4 o;
#pragma unroll
                        for (int i = 0; i < 4; ++i) o[i] = hf[i] + pf[i] * __builtin_amdgcn_rcpf(1.f + __expf(-z[i]));
                        __builtin_nontemporal_store(o, (f32x4*)(out + rowoff + 128 * bj + 16 * n)); } }
    }
};
__device__ __forceinline__ void phase10(const Args& a, const Ctx& c) {
    pg8::DenseOrder S1; S1.init(a.ws + WS_WPG, T, D, D, c.G, (int)blockIdx.x);
    EpiFinal E{(const bf16_t*)(a.ws + WS_H1B), (const bf16_t*)(a.ws + WS_PP), a.b_pg, a.out};
    pg8::gemm_phase(c.lds, (const char*)(a.ws + WS_H1B), D, S1, E);
}

constexpr int N_PHASES = 9 + 2 * NR;
__global__ void __launch_bounds__(512, 2) mega_fwd(Args a) {
    extern __shared__ __attribute__((aligned(16))) unsigned char lds_raw[];
    Ctx c; c.lds = (LAS unsigned char*)lds_raw; c.tid = threadIdx.x; c.lane = c.tid & 63; c.wave = __builtin_amdgcn_readfirstlane(c.tid >> 6);
    c.G = gridDim.x; { const int bx = blockIdx.x; c.vcu = (c.G % 8 == 0) ? (bx % 8) * (c.G / 8) + bx / 8 : bx; }
    volatile LAS unsigned* MISC = (volatile LAS unsigned*)(c.lds + MISC_OFF);
    if (c.tid < 64) MISC[c.tid] = 0u;
    __syncthreads();
    const bool one = (a.ph_hi - a.ph_lo) > 1;
    XcdBarrier bar; bar.bar = (unsigned*)(a.ws + WS_CTL) + CW_BAR; bar.x = 0; bar.st = MISC + 8;
    if (one) bar = xcd_barrier_post((unsigned*)(a.ws + WS_CTL) + CW_BAR, MISC + 8);
#ifndef PH_MASK
#define PH_MASK 0x7fffffff
#endif
#define PH(k) (((PH_MASK >> (k)) & 1) && a.ph_lo <= (k) && (k) < a.ph_hi)
#define SEAM(k) do { if (PH(k) && PH((k) + 1)) xcd_barrier(bar); } while (0)
    if (PH(0)) phase0(a, c);
    SEAM(0);
    if (PH(1)) phase1(a, c);
    SEAM(1);
    if (PH(2)) phase2(a, c);
    SEAM(2);
    if (PH(3)) phase3(a, c);
    SEAM(3);
    if (PH(4)) phase4(a, c);
    SEAM(4);
    if (PH(5)) phase5(a, c);
    SEAM(5);
    if (PH(6)) phase6(a, c);
    SEAM(6);
    for (int r = 0; r < NR; ++r) {
        const int k = 7 + 2 * r;
        if (PH(k)) { if (r > 0) phase9(a, c, r - 1); phase7(a, c, r); }
        SEAM(k);
        if (PH(k + 1)) phase8(a, c, r);
        SEAM(k + 1);
    }
    if (PH(7 + 2 * NR)) phase9(a, c, NR - 1);
    SEAM(7 + 2 * NR);
    if (PH(8 + 2 * NR)) phase10(a, c);
#undef PH
#undef SEAM
}

extern "C" void kernel_launch(void* const* d_in, const int* in_sizes, int n_in, void* d_out, int out_size, void* d_ws, size_t ws_size, hipStream_t stream) {
    static int grid = 0;
    if (grid == 0) {
        if (n_in != 27 || out_size != T * D || ws_size < WS_END) { fprintf(stderr, "kernel_launch: unexpected shapes (n_in %d out %d ws %zu)\n", n_in, out_size, ws_size); grid = -1; return; }
        int dev = 0, cus = 0, per_cu = 0;
        if (hipGetDevice(&dev) != hipSuccess || hipDeviceGetAttribute(&cus, hipDeviceAttributeMultiprocessorCount, dev) != hipSuccess) { grid = -1; return; }
        if (hipFuncSetAttribute((const void*)mega_fwd, hipFuncAttributeMaxDynamicSharedMemorySize, LDS_BYTES) != hipSuccess) { fprintf(stderr, "kernel_launch: hipFuncSetAttribute failed\n"); grid = -1; return; }
        if (hipOccupancyMaxActiveBlocksPerMultiprocessor(&per_cu, (const void*)mega_fwd, 512, LDS_BYTES) != hipSuccess || per_cu < 1) { fprintf(stderr, "kernel_launch: occupancy query says %d\n", per_cu); grid = -1; (void)hipGetLastError(); return; }
        if (cus > 256) cus = 256;
        if (T % (4 * cus * 8) != 0) { fprintf(stderr, "kernel_launch: unsupported CU count %d\n", cus); grid = -1; return; }
        grid = cus;
    }
    if (grid < 0) return;
    (void)hipMemsetAsync((char*)d_ws + WS_CTL, 0, CTL_ZERO_BYTES, stream);
    Args a{};
    a.x = (const float*)d_in[0]; a.p = (const float*)d_in[1]; a.positions = (const int*)d_in[2]; a.ln_emb_g = (const float*)d_in[3]; a.ln_emb_b = (const float*)d_in[4];
    a.w_in = (const float*)d_in[5]; a.w_o = (const float*)d_in[6]; a.lq1 = (const float*)d_in[7]; a.lk1 = (const float*)d_in[8]; a.lq2 = (const float*)d_in[9]; a.lk2 = (const float*)d_in[10];
    a.subln_g = (const float*)d_in[11]; a.ln1_g = (const float*)d_in[12]; a.ln1_b = (const float*)d_in[13]; a.w_router = (const float*)d_in[14]; a.router_bias = (const float*)d_in[15];
    a.w_eg = (const float*)d_in[16]; a.w_eu = (const float*)d_in[17]; a.w_ed = (const float*)d_in[18]; a.w_sg = (const float*)d_in[19]; a.w_su = (const float*)d_in[20]; a.w_sd = (const float*)d_in[21];
    a.ln2_g = (const float*)d_in[22]; a.ln2_b = (const float*)d_in[23]; a.w_pg = (const float*)d_in[24]; a.b_pg = (const float*)d_in[25]; a.w_pp = (const float*)d_in[26];
    a.out = (float*)d_out; a.ws = (unsigned char*)d_ws;
#if MK_N_LAUNCHES == 1
    a.ph_lo = 0; a.ph_hi = N_PHASES;
    void* args[] = {&a};
    hipError_t e = hipLaunchCooperativeKernel((const void*)mega_fwd, dim3(grid), dim3(512), args, LDS_BYTES, stream);
    if (e != hipSuccess) fprintf(stderr, "kernel_launch: cooperative launch failed: %s\n", hipGetErrorString(e));
#else
    for (int ph = 0; ph < N_PHASES; ++ph) { a.ph_lo = ph; a.ph_hi = ph + 1; hipLaunchKernelGGL(mega_fwd, dim3(grid), dim3(512), LDS_BYTES, stream, a); }
#endif
}
```
